# Optimizing an MI355X kernel written in HIP

```python
import jax, jax.numpy as jnp
from jax import lax
import numpy as np


D_MODEL = 1024
BATCH = 8
SEQ = 4096
DEPTH = 4

GRID_W = 64
CTX_LEN = 256
EPS = 1e-6

FOURIER_HEADS = 4
FOURIER_HEAD_DIM = D_MODEL // 8
FOURIER_WIDTH = FOURIER_HEADS * FOURIER_HEAD_DIM
HEAD_DIM = 64
N_Q_HEADS = (D_MODEL // 2) // HEAD_DIM
N_KV_HEADS = 2
GQA_GROUP = N_Q_HEADS // N_KV_HEADS
ATTN_WIDTH = N_Q_HEADS * HEAD_DIM
KV_WIDTH = N_KV_HEADS * HEAD_DIM
Q_END = FOURIER_WIDTH + ATTN_WIDTH
IN_WIDTH = Q_END + 2 * KV_WIDTH
MIX_WIDTH = FOURIER_WIDTH + ATTN_WIDTH
WINDOW = 128
BLOCK = 128
ROPE_THETA = 10000.0
POOL_WINDOWS = (2, 4, 8, 16)
POOL_GROUP = D_MODEL // len(POOL_WINDOWS)
FFN_HIDDEN = ((-(-8 * D_MODEL // 3)) + 255) // 256 * 256
N_EVEN = (DEPTH + 1) // 2
N_ODD = DEPTH // 2

kernel_name = "hybrid_fourier_window_pool_dit"


def rms_norm(x, g):
    xf = x.astype(jnp.float32)
    y = xf * lax.rsqrt(jnp.mean(xf * xf, axis=-1, keepdims=True) + EPS)
    return (y * g.astype(jnp.float32)).astype(x.dtype)


def ada_mod(cond, w, b):
    m = jax.nn.silu(cond) @ w + b
    return jnp.split(m[..., None, :], 6, axis=-1)


def modulate(h, shift, scale):
    return h * (1 + scale) + shift


def axial_rope_tables(n_tokens):
    rows = n_tokens // GRID_W
    row = jnp.repeat(jnp.arange(rows, dtype=jnp.float32), GRID_W)
    col = jnp.tile(jnp.arange(GRID_W, dtype=jnp.float32), rows)
    n_freq = HEAD_DIM // 4
    inv = ROPE_THETA ** (-jnp.arange(n_freq, dtype=jnp.float32) / n_freq)
    ang = jnp.concatenate([row[:, None] * inv[None], col[:, None] * inv[None]], axis=-1)
    return jnp.cos(ang), jnp.sin(ang)


def apply_rope(x, cos, sin):
    xf = x.astype(jnp.float32).reshape(*x.shape[:-1], HEAD_DIM // 2, 2)
    x1, x2 = xf[..., 0], xf[..., 1]
    c, s = cos[:, None, :], sin[:, None, :]
    out = jnp.stack([x1 * c - x2 * s, x1 * s + x2 * c], axis=-1).reshape(x.shape)
    return out.astype(x.dtype)


def fourier_mix(u):
    B, N, _ = u.shape
    uh = u.astype(jnp.float32).reshape(B, N, FOURIER_HEADS, FOURIER_HEAD_DIM)
    y = jnp.fft.fftn(uh, axes=(1, 3), norm='ortho').real
    return y.reshape(B, N, FOURIER_WIDTH).astype(u.dtype)


def sink_logits(sink, lead_shape):
    s = sink.astype(jnp.float32).reshape(1, N_KV_HEADS, GQA_GROUP, 1, 1)
    return jnp.broadcast_to(s, lead_shape + (1,))


def window_attention(q, k, v, k_ctx, v_ctx, sink):
    B, S = q.shape[:2]
    L = k_ctx.shape[1]
    nb = S // BLOCK
    scale = HEAD_DIM ** -0.5
    pad = ((0, 0), (BLOCK, BLOCK), (0, 0), (0, 0))
    kp, vp = jnp.pad(k, pad), jnp.pad(v, pad)
    qb = q.reshape(B, nb, BLOCK, N_KV_HEADS, GQA_GROUP, HEAD_DIM).transpose(1, 0, 2, 3, 4, 5)

    def one_block(args):
        i, q_i = args
        start = i * BLOCK
        k_i = lax.dynamic_slice_in_dim(kp, start, 3 * BLOCK, axis=1)
        v_i = lax.dynamic_slice_in_dim(vp, start, 3 * BLOCK, axis=1)
        qpos = start + jnp.arange(BLOCK)
        kpos = start - BLOCK + jnp.arange(3 * BLOCK)
        valid = (jnp.abs(kpos[None, :] - qpos[:, None]) <= WINDOW) & (kpos[None, :] >= 0) & (kpos[None, :] < S)
        s_win = jnp.einsum('bqkgd,bjkd->bkgqj', q_i, k_i).astype(jnp.float32) * scale
        s_win = jnp.where(valid[None, None, None], s_win, -jnp.inf)
        s_ctx = jnp.einsum('bqkgd,bckd->bkgqc', q_i, k_ctx).astype(jnp.float32) * scale
        logits = jnp.concatenate([s_win, s_ctx, sink_logits(sink, s_win.shape[:-1])], axis=-1)
        p = jax.nn.softmax(logits, axis=-1)
        p_win = p[..., :3 * BLOCK].astype(v.dtype)
        p_ctx = p[..., 3 * BLOCK:3 * BLOCK + L].astype(v.dtype)
        return (jnp.einsum('bkgqj,bjkd->bqkgd', p_win, v_i)
                + jnp.einsum('bkgqc,bckd->bqkgd', p_ctx, v_ctx))

    o = lax.map(one_block, (jnp.arange(nb), qb))
    return o.transpose(1, 0, 2, 3, 4, 5).reshape(B, S, ATTN_WIDTH)


def context_attention(q_c, k_c, v_c, sink):
    B, L = q_c.shape[:2]
    qg = q_c.reshape(B, L, N_KV_HEADS, GQA_GROUP, HEAD_DIM)
    s = jnp.einsum('bqkgd,bckd->bkgqc', qg, k_c).astype(jnp.float32) * HEAD_DIM ** -0.5
    p = jax.nn.softmax(jnp.concatenate([s, sink_logits(sink, s.shape[:-1])], axis=-1), axis=-1)
    p = p[..., :L].astype(v_c.dtype)
    return jnp.einsum('bkgqc,bckd->bqkgd', p, v_c).reshape(B, L, ATTN_WIDTH)


def even_mixer(xn, xcn, w_in, w_out, sink, cos, sin, with_ctx_out):
    B, S, _ = xn.shape
    L = xcn.shape[1]
    proj = xn @ w_in
    f_in = proj[..., :FOURIER_WIDTH]
    q = proj[..., FOURIER_WIDTH:Q_END].reshape(B, S, N_Q_HEADS, HEAD_DIM)
    k = proj[..., Q_END:Q_END + KV_WIDTH].reshape(B, S, N_KV_HEADS, HEAD_DIM)
    v = proj[..., Q_END + KV_WIDTH:].reshape(B, S, N_KV_HEADS, HEAD_DIM)
    q = apply_rope(q, cos, sin)
    k = apply_rope(k, cos, sin)
    kv_c = xcn @ w_in[:, Q_END:]
    k_c = kv_c[..., :KV_WIDTH].reshape(B, L, N_KV_HEADS, HEAD_DIM)
    v_c = kv_c[..., KV_WIDTH:].reshape(B, L, N_KV_HEADS, HEAD_DIM)
    attn = window_attention(q, k, v, k_c, v_c, sink)
    y = jnp.concatenate([fourier_mix(f_in), attn], axis=-1) @ w_out
    if not with_ctx_out:
        return y, None
    fq_c = xcn @ w_in[:, :Q_END]
    f_c = fq_c[..., :FOURIER_WIDTH]
    q_c = fq_c[..., FOURIER_WIDTH:].reshape(B, L, N_Q_HEADS, HEAD_DIM)
    attn_c = context_attention(q_c, k_c, v_c, sink)
    y_c = jnp.concatenate([fourier_mix(f_c), attn_c], axis=-1) @ w_out
    return y, y_c


def pool_mix(h, w_pool, scale):
    B, N, _ = h.shape
    hf = h.astype(jnp.float32)
    csum = jnp.pad(jnp.cumsum(hf, axis=1), ((0, 0), (1, 0), (0, 0)))
    t = np.arange(N)
    outs = []
    for g, w in enumerate(POOL_WINDOWS):
        lo = np.clip(t - w // 2, 0, N)
        hi = np.clip(t + w // 2, 0, N)
        sl = slice(g * POOL_GROUP, (g + 1) * POOL_GROUP)
        cg = csum[..., sl]
        count = jnp.asarray(hi - lo, dtype=jnp.float32)[None, :, None]
        outs.append((cg[:, hi] - cg[:, lo]) / count - hf[..., sl])
    y = jnp.stack(outs, axis=2).astype(h.dtype)
    y = jnp.einsum('bngc,gcd->bngd', y, w_pool).reshape(B, N, D_MODEL)
    return y * scale


def swiglu(h, w1, w3, w2):
    return (jax.nn.silu(h @ w1) * (h @ w3)) @ w2


def setup_inputs(seed: int = 0) -> dict:
    key = jax.random.key(seed)
    ks = jax.random.split(key, 18)
    f32 = jnp.float32

    def nrm(k, shape, s=1.0):
        return s * jax.random.normal(k, shape, f32)

    return {
        'x': nrm(ks[0], (BATCH, SEQ, D_MODEL)),
        'c': nrm(ks[1], (BATCH, D_MODEL)),
        'ctx': nrm(ks[2], (BATCH, CTX_LEN, D_MODEL)),
        'c_ctx': nrm(ks[3], (D_MODEL,)),
        'ada_w': nrm(ks[4], (DEPTH, D_MODEL, 6 * D_MODEL), 0.5 * D_MODEL ** -0.5),
        'ada_b': nrm(ks[5], (DEPTH, 6 * D_MODEL), 0.02),
        'norm_mix_g': 1.0 + nrm(ks[6], (DEPTH, D_MODEL), 0.05),
        'norm_ffn_g': 1.0 + nrm(ks[7], (DEPTH, D_MODEL), 0.05),
        'mix_in_w': nrm(ks[8], (N_EVEN, D_MODEL, IN_WIDTH), D_MODEL ** -0.5),
        'mix_out_w': nrm(ks[9], (N_EVEN, MIX_WIDTH, D_MODEL), MIX_WIDTH ** -0.5),
        'attn_sink': nrm(ks[10], (N_EVEN, N_Q_HEADS), 0.5),
        'pool_w': nrm(ks[11], (N_ODD, len(POOL_WINDOWS), POOL_GROUP, POOL_GROUP), POOL_GROUP ** -0.5),
        'pool_scale': 1.0 + nrm(ks[12], (N_ODD, D_MODEL), 0.1),
        'ffn_w1': nrm(ks[13], (DEPTH, D_MODEL, FFN_HIDDEN), D_MODEL ** -0.5),
        'ffn_w3': nrm(ks[14], (DEPTH, D_MODEL, FFN_HIDDEN), D_MODEL ** -0.5),
        'ffn_w2': nrm(ks[15], (DEPTH, FFN_HIDDEN, D_MODEL), FFN_HIDDEN ** -0.5),
        'final_g': 1.0 + nrm(ks[16], (D_MODEL,), 0.05),
    }


def reference(x, c, ctx, c_ctx, ada_w, ada_b, norm_mix_g, norm_ffn_g, mix_in_w, mix_out_w,
              attn_sink, pool_w, pool_scale, ffn_w1, ffn_w3, ffn_w2, final_g):
    n_tokens = x.shape[1]
    cos, sin = axial_rope_tables(n_tokens)
    last_ctx_reader = max(range(0, DEPTH, 2))
    h, hc = x, ctx
    for layer in range(DEPTH):
        sh1, sc1, g1, sh2, sc2, g2 = ada_mod(c, ada_w[layer], ada_b[layer])
        update_ctx = layer < last_ctx_reader
        need_ctx_in = update_ctx or (layer % 2 == 0 and layer <= last_ctx_reader)
        if need_ctx_in:
            csh1, csc1, cg1, csh2, csc2, cg2 = ada_mod(c_ctx, ada_w[layer], ada_b[layer])
            xcn = modulate(rms_norm(hc, norm_mix_g[layer]), csh1, csc1)
        xn = modulate(rms_norm(h, norm_mix_g[layer]), sh1, sc1)
        j = layer // 2
        if layer % 2 == 0:
            y, y_c = even_mixer(xn, xcn, mix_in_w[j], mix_out_w[j], attn_sink[j], cos, sin, update_ctx)
        else:
            y = pool_mix(xn, pool_w[j], pool_scale[j])
            y_c = pool_mix(xcn, pool_w[j], pool_scale[j]) if update_ctx else None
        h = h + g1 * y
        hn = modulate(rms_norm(h, norm_ffn_g[layer]), sh2, sc2)
        h = h + g2 * swiglu(hn, ffn_w1[layer], ffn_w3[layer], ffn_w2[layer])
        if update_ctx:
            hc = hc + cg1 * y_c
            hcn = modulate(rms_norm(hc, norm_ffn_g[layer]), csh2, csc2)
            hc = hc + cg2 * swiglu(hcn, ffn_w1[layer], ffn_w3[layer], ffn_w2[layer])
    return rms_norm(h, final_g)
```

```cpp
#include <hip/hip_runtime.h>
#include <hip/hip_cooperative_groups.h>
#include <cstdio>
#include <cstdint>
namespace cg = cooperative_groups;

#define LAS __attribute__((address_space(3)))
typedef unsigned short bf16_t;
typedef short bf16x8 __attribute__((ext_vector_type(8)));
typedef short s16x4 __attribute__((ext_vector_type(4)));
typedef float f32x4 __attribute__((ext_vector_type(4)));
typedef float f32x2 __attribute__((ext_vector_type(2)));
typedef float f32x16 __attribute__((ext_vector_type(16)));
typedef unsigned u32x4 __attribute__((ext_vector_type(4)));
typedef unsigned u32x2 __attribute__((ext_vector_type(2)));

constexpr int D = 1024, NB = 8, SEQ = 4096, NLAT = NB * SEQ, CTX = 256, NCTX = NB * CTX, MALL = NLAT + NCTX, FF = 2816, DEPTH = 4;
constexpr int MODW = 6 * D;
constexpr float EPS = 1e-6f;
constexpr float QSCALE = 0.125f * 1.4426950408889634f;
constexpr float LOG2E = 1.4426950408889634f;

constexpr size_t MiB = 1u << 20;
constexpr size_t WS_MOD = 0, WS_ROPE = 1 * MiB, WS_DFT256 = 2 * MiB, WS_HC = 3 * MiB, WS_HB = 11 * MiB, WS_XN = 75 * MiB;
constexpr size_t WS_W13 = 143 * MiB, WS_W2 = 187 * MiB, WS_WQKV = 209 * MiB, WS_WF = 212 * MiB, WS_WO = 216 * MiB, WS_WP = 220 * MiB;
constexpr size_t WS_U = 221 * MiB;
constexpr size_t WS_Q = 221 * MiB, WS_K = 255 * MiB, WS_VT = 264 * MiB, WS_VTC = 272 * MiB, WS_FT = 273 * MiB, WS_FTC = 337 * MiB, WS_MIX = 341 * MiB;
constexpr size_t WS_FTF = 410 * MiB;
constexpr size_t WS_SLAB = 442 * MiB;
constexpr size_t WS_DFT = 458 * MiB;
constexpr size_t WS_END = 490 * MiB;
constexpr size_t WS_BAR = 1 * MiB + 512 * 1024, BAR_BYTES = 16384;
constexpr size_t W13_L = (size_t)2 * FF * D, W2_L = (size_t)D * FF, WQKV_L = (size_t)768 * D, WF_L = (size_t)1024 * D, WO_L = (size_t)D * D, WP_L = (size_t)4 * 256 * 256;

constexpr int LDS_BYTES = 147456;

__device__ __forceinline__ unsigned cvt_pk_bf16(float lo, float hi) { unsigned r; asm volatile("v_cvt_pk_bf16_f32 %0, %1, %2" : "=v"(r) : "v"(lo), "v"(hi)); return r; }
__device__ __forceinline__ float wave_sum(float v) {
#pragma unroll
    for (int o = 1; o < 64; o <<= 1) v += __shfl_xor(v, o);
    return v;
}
__device__ __forceinline__ int opaque_tid() { int t = threadIdx.x; asm volatile("" : "+v"(t)); return t; }
__device__ __forceinline__ f32x4 ld4(const float* p) { return *(const f32x4*)p; }
__device__ __forceinline__ f32x4 ld4(const bf16_t* p) { const u32x2 w = *(const u32x2*)p; return (f32x4){__uint_as_float(w.x << 16), __uint_as_float(w.x & 0xffff0000u), __uint_as_float(w.y << 16), __uint_as_float(w.y & 0xffff0000u)}; }
__device__ __forceinline__ f32x2 ld2(const float* p) { return *(const f32x2*)p; }
__device__ __forceinline__ f32x2 ld2(const bf16_t* p) { const unsigned w = *(const unsigned*)p; return (f32x2){__uint_as_float(w << 16), __uint_as_float(w & 0xffff0000u)}; }
__device__ __forceinline__ float silu_f(float x) { return x * __builtin_amdgcn_rcpf(1.0f + __expf(-x)); }
__device__ __forceinline__ void silu_mul8(f32x4 a0, f32x4 b0, f32x4 a1, f32x4 b1, f32x4& o0, f32x4& o1) {
    const f32x4 t0 = a0 * (-1.4426950408889634f), t1 = a1 * (-1.4426950408889634f);
    f32x4 e0, e1;
#pragma unroll
    for (int j = 0; j < 4; ++j) { e0[j] = __builtin_amdgcn_exp2f(t0[j]); e1[j] = __builtin_amdgcn_exp2f(t1[j]); }
    const f32x4 d0 = e0 + 1.0f, d1 = e1 + 1.0f;
    f32x4 r0, r1;
#pragma unroll
    for (int j = 0; j < 4; ++j) { r0[j] = __builtin_amdgcn_rcpf(d0[j]); r1[j] = __builtin_amdgcn_rcpf(d1[j]); }
    o0 = (a0 * b0) * r0; o1 = (a1 * b1) * r1;
}

namespace pg8 {
constexpr int BM = 256, BK = 64, HALF = 128, HTB = HALF * BK * 2, STAGE_BYTES = 8 * HTB, WGM = 8;
__device__ __forceinline__ int lds_byte(int r, int c) { const int st = (r >> 4) * 2 + (c >> 5), rr = r & 15, cc = c & 31, ob = rr * 64 + cc * 2; return st * 1024 + (ob ^ (((ob >> 9) & 1) << 5)); }
__device__ __forceinline__ void stage_rc(int b, int& R, int& C) { const int st = b / 1024, sb = b % 1024, swz = sb ^ (((sb >> 9) & 1) << 5); R = (st >> 1) * 16 + swz / 64; C = (st & 1) * 32 + (swz % 64) / 2; }
__device__ __forceinline__ int perm32(int rho) { const int n = rho >> 4, i = rho & 15; return 8 * (i >> 2) + 4 * n + (i & 3); }

struct Unit { int pm, pn, z; };
struct Gemm { const bf16_t* A; const bf16_t* Bt; int K, lda, ldb; long sA, sB; };

struct Order {
    int nN, nZ, per, G, vcu, gsh, zfast; unsigned nig, inv;
    __device__ __forceinline__ Order(int nM_, int nN_, int nZ_, int G_, int vcu_, int gsh_, int zfast_ = 0) {
        nN = nN_; nZ = nZ_; per = nM_ * nN_; G = G_; vcu = vcu_; gsh = gsh_; zfast = zfast_; nig = (unsigned)nN_ << gsh_;
        inv = (unsigned)__builtin_amdgcn_readfirstlane((int)((1u << 24) / nig + 1u));
    }
    __device__ __forceinline__ bool next(int i, Unit& u) const {
        const unsigned L = (unsigned)i * (unsigned)G + (unsigned)vcu;
        if (L >= (unsigned)per * (unsigned)nZ) return false;
        unsigned z, w;
        if (nZ == 1) { z = 0u; w = L; }
        else if (zfast) { z = L % (unsigned)nZ; w = L / (unsigned)nZ; }
        else { z = L / (unsigned)per; w = L - z * (unsigned)per; }
        const unsigned gid = (w * inv) >> 24, r = w - gid * nig;
        u.pm = (int)((gid << gsh) + (r & ((1u << gsh) - 1u))); u.pn = (int)(r >> gsh); u.z = (int)z; return true;
    }
};

template <class Epi>
__device__ __forceinline__ void gemm_phase(LAS unsigned char* lds, const Gemm g, const Order& S, const Epi& E) {
    const int tid = opaque_tid(), wid = __builtin_amdgcn_readfirstlane(tid >> 6), lane = tid & 63, wr = wid >> 2, wc = wid & 3, fr = lane & 15, fq = lane >> 4;
    const int K = g.K, nt = K / BK;
    unsigned voffA[2], voffB[2];
#pragma unroll
    for (int i = 0; i < 2; ++i) { int R, C; stage_rc(tid * 16 + i * 8192, R, C); const int Rb = Epi::PERM ? ((R & ~31) + perm32(R & 31)) : R;
        voffA[i] = (unsigned)(R * g.lda + C) * 2u; voffB[i] = (unsigned)(Rb * g.ldb + C) * 2u; }
    const size_t kstep = (size_t)(BK * 2);
    const size_t hstepA = (size_t)HALF * g.lda * 2, hstepB = (size_t)HALF * g.ldb * 2;
    const size_t tstepA = 2 * hstepA, tstepB = 2 * hstepB;
    const unsigned ldsw = (unsigned)wid * 1024u;
    const int aoff = lds_byte(wr * 64 + fr, fq * 8), boff = lds_byte(wc * 32 + fr, fq * 8);
#define PG8_SA(b, h) (((b) * 2 + (h)) * HTB)
#define PG8_SB(b, h) ((4 + (b) * 2 + (h)) * HTB)
#define PG8_STAGE(bufoff, gbase, voff) do { _Pragma("unroll") for (int _i = 0; _i < 2; ++_i) \
        __builtin_amdgcn_global_load_lds((const unsigned*)((const char*)(gbase) + (voff)[_i]), (LAS unsigned*)(lds + (bufoff) + ldsw + _i * 8192), 16, 0, 0); } while (0)
#define PG8_LDA(dst, b, h) do { _Pragma("unroll") for (int m = 0; m < 4; ++m) _Pragma("unroll") for (int k = 0; k < 2; ++k) dst[m][k] = *(const LAS bf16x8*)(lds + PG8_SA(b, h) + aoff + m * 2048 + k * 1024); } while (0)
#define PG8_LDB(dst, b, h) do { _Pragma("unroll") for (int n = 0; n < 2; ++n) _Pragma("unroll") for (int k = 0; k < 2; ++k) dst[n][k] = *(const LAS bf16x8*)(lds + PG8_SB(b, h) + boff + n * 2048 + k * 1024); } while (0)
#define PG8_MMA(ai, bj, At, Bt) do { __builtin_amdgcn_s_setprio(1); _Pragma("unroll") for (int m = 0; m < 4; ++m) _Pragma("unroll") for (int n = 0; n < 2; ++n) _Pragma("unroll") for (int k = 0; k < 2; ++k) \
        acc[ai][bj][m][n] = __builtin_amdgcn_mfma_f32_16x16x32_bf16(Bt[n][k], At[m][k], acc[ai][bj][m][n], 0, 0, 0); __builtin_amdgcn_s_setprio(0); } while (0)
#define PG8_WAIT_V(n) asm volatile("s_waitcnt vmcnt(" #n ")" ::: "memory")
#define PG8_WAIT_L(n) asm volatile("s_waitcnt lgkmcnt(" #n ")" ::: "memory")
#define PG8_BAR __builtin_amdgcn_s_barrier()
#define PG8_SCHED __builtin_amdgcn_sched_barrier(0)
#define PG8_UA(u) ((const char*)g.A + ((size_t)(u).z * (size_t)g.sA) * 2 + (size_t)(u).pm * tstepA)
#define PG8_UB(u) ((const char*)g.Bt + ((size_t)(u).z * (size_t)g.sB) * 2 + (size_t)(u).pn * tstepB)
    Unit cur, nxt; int ui = 0;
    if (!S.next(0, cur)) return;
    f32x4 acc[2][2][4][2];
#pragma unroll
    for (int a = 0; a < 2; ++a)
#pragma unroll
        for (int b = 0; b < 2; ++b)
#pragma unroll
            for (int m = 0; m < 4; ++m)
#pragma unroll
                for (int n = 0; n < 2; ++n) acc[a][b][m][n] = (f32x4){0.f, 0.f, 0.f, 0.f};
    bf16x8 At[4][2], B0[2][2], B1[2][2];
    const char* cA = PG8_UA(cur); const char* cB = PG8_UB(cur);
    PG8_STAGE(PG8_SB(0, 0), cB, voffB); PG8_STAGE(PG8_SB(0, 1), cB + hstepB, voffB); PG8_STAGE(PG8_SA(0, 0), cA, voffA); PG8_STAGE(PG8_SA(0, 1), cA + hstepA, voffA);
    if (wr == 1) PG8_BAR;
    PG8_WAIT_V(2); PG8_BAR;
    PG8_STAGE(PG8_SB(1, 0), cB + kstep, voffB); PG8_STAGE(PG8_SA(1, 0), cA + kstep, voffA); PG8_STAGE(PG8_SB(1, 1), cB + hstepB + kstep, voffB);
    PG8_WAIT_V(6); PG8_BAR;
    for (;;) {
        const bool has_next = S.next(ui + 1, nxt);
        const char* nA = has_next ? PG8_UA(nxt) : cA; const char* nB = has_next ? PG8_UB(nxt) : cB;
        for (int t = 0; t < nt; t += 2) {
            const bool last = (t == nt - 2);
            const char* a1 = cA + (size_t)(t + 1) * kstep;
            const char* a2 = last ? nA : cA + (size_t)(t + 2) * kstep; const char* b2 = last ? nB : cB + (size_t)(t + 2) * kstep;
            const char* a3 = a2 + kstep; const char* b3 = b2 + kstep;
            PG8_LDB(B0, 0, 0); PG8_LDB(B1, 0, 1); PG8_SCHED; PG8_LDA(At, 0, 0); PG8_STAGE(PG8_SA(1, 1), a1 + hstepA, voffA);
            PG8_WAIT_V(8); PG8_WAIT_L(0); PG8_BAR; PG8_MMA(0, 0, At, B0); PG8_MMA(0, 1, At, B1); PG8_BAR; PG8_SCHED;
            PG8_LDA(At, 0, 1); PG8_STAGE(PG8_SB(0, 0), b2, voffB); PG8_STAGE(PG8_SB(0, 1), b2 + hstepB, voffB); PG8_STAGE(PG8_SA(0, 0), a2, voffA);
            PG8_WAIT_V(8); PG8_WAIT_L(0); PG8_BAR; PG8_MMA(1, 0, At, B0); PG8_MMA(1, 1, At, B1); PG8_BAR; PG8_SCHED;
            PG8_LDB(B0, 1, 0); PG8_LDB(B1, 1, 1); PG8_SCHED; PG8_LDA(At, 1, 0); PG8_STAGE(PG8_SA(0, 1), a2 + hstepA, voffA);
            PG8_WAIT_V(8); PG8_WAIT_L(0); PG8_BAR; PG8_MMA(0, 0, At, B0); PG8_MMA(0, 1, At, B1); PG8_BAR; PG8_SCHED;
            PG8_LDA(At, 1, 1); PG8_STAGE(PG8_SB(1, 0), b3, voffB); PG8_STAGE(PG8_SB(1, 1), b3 + hstepB, voffB); PG8_STAGE(PG8_SA(1, 0), a3, voffA);
            PG8_WAIT_V(8); PG8_WAIT_L(0); PG8_BAR; PG8_MMA(1, 0, At, B0); PG8_MMA(1, 1, At, B1); PG8_BAR; PG8_SCHED;
        }
        if (wr == 0) PG8_BAR;
        E(acc, cur, wr, wc, fr, fq);
        if (!has_next) break;
#pragma unroll
        for (int a = 0; a < 2; ++a)
#pragma unroll
            for (int b = 0; b < 2; ++b)
#pragma unroll
                for (int m = 0; m < 4; ++m)
#pragma unroll
                    for (int n = 0; n < 2; ++n) acc[a][b][m][n] = (f32x4){0.f, 0.f, 0.f, 0.f};
        cur = nxt; cA = nA; cB = nB; ++ui;
        if (wr == 1) PG8_BAR;
    }
    PG8_WAIT_V(0);
    PG8_BAR;
#undef PG8_SA
#undef PG8_SB
#undef PG8_STAGE
#undef PG8_LDA
#undef PG8_LDB
#undef PG8_MMA
#undef PG8_WAIT_V
#undef PG8_WAIT_L
#undef PG8_BAR
#undef PG8_SCHED
#undef PG8_UA
#undef PG8_UB
}

typedef const f32x4 (&AccRef)[2][2][4][2];

struct EpiStore {
    static constexpr bool PERM = true;
    bf16_t* O; int ldc; long zoff;
    __device__ __forceinline__ void operator()(AccRef acc, const Unit& u, int wr, int wc, int fr, int fq) const {
        bf16_t* base = O + (size_t)u.z * zoff + (size_t)(u.pm * BM + wr * 64 + fr) * ldc + u.pn * BM + wc * 32 + 8 * fq;
#pragma unroll
        for (int ai = 0; ai < 2; ++ai)
#pragma unroll
            for (int m = 0; m < 4; ++m) { bf16_t* rowp = base + (size_t)(ai * HALF + m * 16) * ldc;
#pragma unroll
                for (int bj = 0; bj < 2; ++bj) { const f32x4 v0 = acc[ai][bj][m][0], v1 = acc[ai][bj][m][1];
                    u32x4 w; w.x = cvt_pk_bf16(v0[0], v0[1]); w.y = cvt_pk_bf16(v0[2], v0[3]); w.z = cvt_pk_bf16(v1[0], v1[1]); w.w = cvt_pk_bf16(v1[2], v1[3]);
                    *(u32x4*)(rowp + bj * HALF) = w; } }
    }
};

struct EpiFT {
    static constexpr bool PERM = true;
    bf16_t* FT; bf16_t* FTc;
    __device__ __forceinline__ void operator()(AccRef acc, const Unit& u, int wr, int wc, int fr, int fq) const {
        const int tl = wc * 32 + 8 * fq;
        bf16_t* base; size_t rstride; int poff;
        if (u.pn < 128) { const int b = u.pn >> 4; const int n = ((u.pn & 15) << 8) + tl; base = FT + (size_t)b * 512 * 8192 + n; rstride = 8192; poff = 4096; }
        else { const int b = u.pn - 128; base = FTc + (size_t)b * 512 * 512 + tl; rstride = 512; poff = 256; }
#pragma unroll
        for (int ai = 0; ai < 2; ++ai)
#pragma unroll
            for (int m = 0; m < 4; ++m) { const int R = u.pm * BM + ai * HALF + wr * 64 + m * 16 + fr; const int part = R >> 9, c = R & 511;
                bf16_t* rowp = base + (size_t)c * rstride + part * poff;
#pragma unroll
                for (int bj = 0; bj < 2; ++bj) { const f32x4 v0 = acc[ai][bj][m][0], v1 = acc[ai][bj][m][1];
                    u32x4 w; w.x = cvt_pk_bf16(v0[0], v0[1]); w.y = cvt_pk_bf16(v0[2], v0[3]); w.z = cvt_pk_bf16(v1[0], v1[1]); w.w = cvt_pk_bf16(v1[2], v1[3]);
                    *(u32x4*)(rowp + bj * HALF) = w; } }
    }
};

struct EpiQKV {
    static constexpr bool PERM = true;
    bf16_t* Q; bf16_t* Kb; const float* rope;
    __device__ __forceinline__ void operator()(AccRef acc, const Unit& u, int wr, int wc, int fr, int fq) const {
        const bool isctx = u.pm >= (NLAT / BM);
#pragma unroll
        for (int ai = 0; ai < 2; ++ai) {
            f32x4 csa[4], csb[4];
#pragma unroll
            for (int m = 0; m < 4; ++m) { const int pos = (u.pm * BM + ai * HALF + wr * 64 + m * 16 + fr) & (SEQ - 1); const int pp = (wc & 1) ? (pos & 63) : (pos >> 6);
                csa[m] = (f32x4){1.f, 0.f, 1.f, 0.f}; csb[m] = csa[m];
                if (!isctx) { const f32x4* tp = (const f32x4*)(rope + (size_t)(pp * 16 + 4 * fq) * 2); csa[m] = tp[0]; csb[m] = tp[1]; } }
            asm volatile("" ::: "memory");
#pragma unroll
            for (int m = 0; m < 4; ++m) {
                const int R = u.pm * BM + ai * HALF + wr * 64 + m * 16 + fr;
                const int pos = R & (SEQ - 1);
                const f32x4 cs0 = csa[m], cs1 = csb[m];
#pragma unroll
                for (int bj = 0; bj < 2; ++bj) {
                    f32x4 v0 = acc[ai][bj][m][0], v1 = acc[ai][bj][m][1];
                    if (u.pn < 2 || bj == 0) {
                        f32x4 o0, o1;
                        o0[0] = v0[0] * cs0[0] - v0[1] * cs0[1]; o0[1] = v0[0] * cs0[1] + v0[1] * cs0[0];
                        o0[2] = v0[2] * cs0[2] - v0[3] * cs0[3]; o0[3] = v0[2] * cs0[3] + v0[3] * cs0[2];
                        o1[0] = v1[0] * cs1[0] - v1[1] * cs1[1]; o1[1] = v1[0] * cs1[1] + v1[1] * cs1[0];
                        o1[2] = v1[2] * cs1[2] - v1[3] * cs1[3]; o1[3] = v1[2] * cs1[3] + v1[3] * cs1[2];
                        if (u.pn < 2) { o0 = o0 * QSCALE; o1 = o1 * QSCALE; }
                        v0 = o0; v1 = o1;
                    }
                    u32x4 w; w.x = cvt_pk_bf16(v0[0], v0[1]); w.y = cvt_pk_bf16(v0[2], v0[3]); w.z = cvt_pk_bf16(v1[0], v1[1]); w.w = cvt_pk_bf16(v1[2], v1[3]);
                    if (u.pn < 2) *(u32x4*)(Q + (size_t)R * 512 + u.pn * BM + bj * HALF + wc * 32 + 8 * fq) = w;
                    else *(u32x4*)(Kb + (size_t)R * 256 + bj * HALF + wc * 32 + 8 * fq) = w;
                }
                asm volatile("" ::: "memory");
            }
        }
    }
};

struct EpiSwiGLU {
    static constexpr bool PERM = true;
    bf16_t* U;
    __device__ __forceinline__ void operator()(AccRef acc, const Unit& u, int wr, int wc, int fr, int fq) const {
        bf16_t* base = U + (size_t)(u.pm * BM + wr * 64 + fr) * FF + u.pn * HALF + wc * 32 + 8 * fq;
#pragma unroll
        for (int ai = 0; ai < 2; ++ai)
#pragma unroll
            for (int m = 0; m < 4; ++m) { bf16_t* rowp = base + (size_t)(ai * HALF + m * 16) * FF;
                f32x4 o0, o1; silu_mul8(acc[ai][0][m][0], acc[ai][1][m][0], acc[ai][0][m][1], acc[ai][1][m][1], o0, o1);
                u32x4 w; w.x = cvt_pk_bf16(o0[0], o0[1]); w.y = cvt_pk_bf16(o0[2], o0[3]); w.z = cvt_pk_bf16(o1[0], o1[1]); w.w = cvt_pk_bf16(o1[2], o1[3]);
                *(u32x4*)(rowp) = w; }
    }
};

template <class TB> struct EpiResH {
    static constexpr bool PERM = true;
    const TB* baseL; const TB* baseC; bf16_t* outL; bf16_t* outC; const float* gate;
    int zcol;
    static __device__ __forceinline__ void ld8(const float* p, f32x4& a, f32x4& b) { a = *(const f32x4*)p; b = *(const f32x4*)(p + 4); }
    static __device__ __forceinline__ void ld8(const bf16_t* p, f32x4& a, f32x4& b) { const u32x4 w = *(const u32x4*)p;
        a = (f32x4){__uint_as_float(w.x << 16), __uint_as_float(w.x & 0xffff0000u), __uint_as_float(w.y << 16), __uint_as_float(w.y & 0xffff0000u)};
        b = (f32x4){__uint_as_float(w.z << 16), __uint_as_float(w.z & 0xffff0000u), __uint_as_float(w.w << 16), __uint_as_float(w.w & 0xffff0000u)}; }
    __device__ __forceinline__ void operator()(AccRef acc, const Unit& u, int wr, int wc, int fr_, int fq_) const {
        int fr = fr_, fq = fq_; asm volatile("" : "+v"(fr), "+v"(fq));
        const int r0 = u.pm * BM; const TB* bs; bf16_t* os; int mb;
        if (r0 < NLAT) { bs = baseL + (size_t)r0 * D; os = outL + (size_t)r0 * D; mb = r0 >> 12; }
        else { bs = baseC + (size_t)(r0 - NLAT) * D; os = outC + (size_t)(r0 - NLAT) * D; mb = 8; }
        const int col0 = u.z * zcol + u.pn * BM + wc * 32 + 8 * fq;
        f32x4 gv[2][2];
#pragma unroll
        for (int bj = 0; bj < 2; ++bj)
#pragma unroll
            for (int n = 0; n < 2; ++n) gv[bj][n] = *(const f32x4*)(gate + (size_t)mb * MODW + col0 + bj * HALF + 4 * n);
#pragma unroll
        for (int ai = 0; ai < 2; ++ai) {
            f32x4 b4[4][2][2];
#pragma unroll
            for (int mm = 0; mm < 4; ++mm) { const unsigned off = (unsigned)((ai * HALF + wr * 64 + mm * 16 + fr) * D + col0);
#pragma unroll
                for (int bj = 0; bj < 2; ++bj) ld8(bs + off + bj * HALF, b4[mm][bj][0], b4[mm][bj][1]); }
            asm volatile("" ::: "memory");
#pragma unroll
            for (int mm = 0; mm < 4; ++mm) { const unsigned off = (unsigned)((ai * HALF + wr * 64 + mm * 16 + fr) * D + col0);
#pragma unroll
                for (int bj = 0; bj < 2; ++bj) { const f32x4 o0 = b4[mm][bj][0] + gv[bj][0] * acc[ai][bj][mm][0], o1 = b4[mm][bj][1] + gv[bj][1] * acc[ai][bj][mm][1];
                    u32x4 w; w.x = cvt_pk_bf16(o0[0], o0[1]); w.y = cvt_pk_bf16(o0[2], o0[3]); w.z = cvt_pk_bf16(o1[0], o1[1]); w.w = cvt_pk_bf16(o1[2], o1[3]);
                    *(u32x4*)(os + off + bj * HALF) = w; } }
            asm volatile("" ::: "memory"); }
    }
};
struct EpiPartial {
    static constexpr bool PERM = false;
    float* S; long zoff;
    __device__ __forceinline__ void operator()(AccRef acc, const Unit& u, int wr, int wc, int fr, int fq) const {
        float* os = S + (size_t)u.z * zoff + (size_t)(u.pm * BM) * D + u.pn * BM + wc * 32 + 4 * fq;
#pragma unroll
        for (int ai = 0; ai < 2; ++ai)
#pragma unroll
            for (int m = 0; m < 4; ++m) { const size_t off = (size_t)(ai * HALF + wr * 64 + m * 16 + fr) * D;
#pragma unroll
                for (int bj = 0; bj < 2; ++bj)
#pragma unroll
                    for (int n = 0; n < 2; ++n) *(f32x4*)(os + off + bj * HALF + n * 16) = acc[ai][bj][m][n]; }
    }
};
}

namespace att {
constexpr int KSTR = 144, VSTR = 264;
constexpr int KBUF = 128 * KSTR, VBUF = 64 * VSTR, BUF = KBUF + VBUF;
struct Args { const bf16_t* Q; const bf16_t* Kb; bf16_t* MIX; const float* sink; };
__device__ __forceinline__ int crow(int r, int hi) { return (r & 3) + 8 * (r >> 2) + 4 * hi; }

__device__ __forceinline__ void unit(LAS unsigned char* lds, const Args& A, int b, int blk, int kvh) {
    const int tid = opaque_tid(), lane = tid & 63, r32 = lane & 31, hi = lane >> 5, wid = __builtin_amdgcn_readfirstlane(tid >> 6);
    const bool cq = blk >= 32;
    const int hq = kvh * 4 + (wid >> 1);
    const int qloc = (wid & 1) * 64;
    const size_t qrow0 = cq ? (size_t)NLAT + b * CTX + (blk - 32) * 128 : (size_t)b * SEQ + blk * 128;
    bf16x8 qf[2][4];
#pragma unroll
    for (int qt = 0; qt < 2; ++qt)
#pragma unroll
        for (int ks = 0; ks < 4; ++ks) qf[qt][ks] = *(const bf16x8*)(A.Q + (qrow0 + qloc + qt * 32 + r32) * 512 + hq * 64 + ks * 16 + hi * 8);
    f32x16 o[2][2];
#pragma unroll
    for (int a = 0; a < 2; ++a)
#pragma unroll
        for (int c = 0; c < 2; ++c)
#pragma unroll
            for (int r = 0; r < 16; ++r) o[a][c][r] = 0.f;
    const float sk = A.sink[hq] * LOG2E;
    float mrow[2] = {sk, sk}, lrow[2] = {hi == 0 ? 1.f : 0.f, hi == 0 ? 1.f : 0.f};
    const int c_first = cq ? 3 : (blk == 0 ? 1 : 0);
    u32x4 kreg[2], vreg[2];
    auto next_chunk = [&](int c) { int n = c + 1; if (!cq && n == 2 && blk == 31) n = 3; return n; };
    auto gload = [&](int c) {
#pragma unroll
        for (int i = 0; i < 2; ++i) {
            const int p = tid + 512 * i;
            const int key = p >> 3, part = p & 7;
            size_t krow;
            if (c < 3) krow = (size_t)b * SEQ + blk * 128 + (c - 1) * 128 + key; else krow = (size_t)NLAT + b * CTX + (c - 3) * 128 + key;
            kreg[i] = *(const u32x4*)(A.Kb + krow * 256 + kvh * 64 + part * 8);
            vreg[i] = *(const u32x4*)(A.Kb + krow * 256 + 128 + kvh * 64 + part * 8);
        }
    };
    auto lstore = [&](int buf) {
        LAS unsigned char* kb = lds + buf * BUF; LAS unsigned char* vb = kb + KBUF;
#pragma unroll
        for (int i = 0; i < 2; ++i) {
            const int p = tid + 512 * i; const int key = p >> 3, part = p & 7;
            *(LAS u32x4*)(kb + key * KSTR + part * 16) = kreg[i];
            LAS unsigned short* vp = (LAS unsigned short*)(vb + (part * 8) * VSTR + key * 2);
            const unsigned x0 = vreg[i].x, x1 = vreg[i].y, x2 = vreg[i].z, x3 = vreg[i].w;
            vp[0 * (VSTR / 2)] = (unsigned short)(x0 & 0xffff); vp[1 * (VSTR / 2)] = (unsigned short)(x0 >> 16);
            vp[2 * (VSTR / 2)] = (unsigned short)(x1 & 0xffff); vp[3 * (VSTR / 2)] = (unsigned short)(x1 >> 16);
            vp[4 * (VSTR / 2)] = (unsigned short)(x2 & 0xffff); vp[5 * (VSTR / 2)] = (unsigned short)(x2 >> 16);
            vp[6 * (VSTR / 2)] = (unsigned short)(x3 & 0xffff); vp[7 * (VSTR / 2)] = (unsigned short)(x3 >> 16);
        }
    };
    gload(c_first); lstore(0); __syncthreads();
    int buf = 0;
    for (int c = c_first; c < 5;) {
        const int cn = next_chunk(c);
        if (cn < 5) gload(cn);
        LAS unsigned char* kb = lds + buf * BUF; LAS unsigned char* vb = kb + KBUF;
#pragma unroll 1
        for (int kt = 0; kt < 4; ++kt) {
            f32x16 s[2];
#pragma unroll
            for (int r = 0; r < 16; ++r) { s[0][r] = 0.f; s[1][r] = 0.f; }
#pragma unroll
            for (int ks = 0; ks < 4; ++ks) {
                const bf16x8 kf = *(const LAS bf16x8*)(kb + (kt * 32 + r32) * KSTR + (ks * 16 + hi * 8) * 2);
                s[0] = __builtin_amdgcn_mfma_f32_32x32x16_bf16(kf, qf[0][ks], s[0], 0, 0, 0);
                s[1] = __builtin_amdgcn_mfma_f32_32x32x16_bf16(kf, qf[1][ks], s[1], 0, 0, 0);
            }
            if (c == 0 || c == 2) {
#pragma unroll
                for (int qt = 0; qt < 2; ++qt) { const int q = qloc + qt * 32 + r32;
#pragma unroll
                    for (int r = 0; r < 16; ++r) { const int j = kt * 32 + crow(r, hi); const bool ok = (c == 0) ? (j >= q) : (j <= q); if (!ok) s[qt][r] = -INFINITY; } }
            }
            bf16x8 pb[2][2];
#pragma unroll
            for (int qt = 0; qt < 2; ++qt) {
                float mx = s[qt][0];
#pragma unroll
                for (int r = 1; r < 16; ++r) mx = fmaxf(mx, s[qt][r]);
                mx = fmaxf(mx, __shfl_xor(mx, 32));
                const float mnew = fmaxf(mrow[qt], mx);
                const float alpha = __builtin_amdgcn_exp2f(mrow[qt] - mnew);
                mrow[qt] = mnew;
                float ls = 0.f;
#pragma unroll
                for (int r = 0; r < 16; ++r) { const float pv = __builtin_amdgcn_exp2f(s[qt][r] - mnew); s[qt][r] = pv; ls += pv; }
                lrow[qt] = lrow[qt] * alpha + ls;
#pragma unroll
                for (int dt = 0; dt < 2; ++dt)
#pragma unroll
                    for (int r = 0; r < 16; ++r) o[dt][qt][r] *= alpha;
#pragma unroll
                for (int st = 0; st < 2; ++st) {
                    u32x4 w; w.x = cvt_pk_bf16(s[qt][8 * st + 0], s[qt][8 * st + 1]); w.y = cvt_pk_bf16(s[qt][8 * st + 2], s[qt][8 * st + 3]);
                    w.z = cvt_pk_bf16(s[qt][8 * st + 4], s[qt][8 * st + 5]); w.w = cvt_pk_bf16(s[qt][8 * st + 6], s[qt][8 * st + 7]);
                    pb[qt][st] = __builtin_bit_cast(bf16x8, w);
                }
            }
#pragma unroll
            for (int st = 0; st < 2; ++st)
#pragma unroll
                for (int dt = 0; dt < 2; ++dt) {
                    const LAS unsigned char* vp = vb + (dt * 32 + r32) * VSTR + (kt * 32 + st * 16 + hi * 4) * 2;
                    const u32x2 lo = *(const LAS u32x2*)vp, hh = *(const LAS u32x2*)(vp + 16);
                    const bf16x8 vf = __builtin_bit_cast(bf16x8, (u32x4){lo.x, lo.y, hh.x, hh.y});
                    o[dt][0] = __builtin_amdgcn_mfma_f32_32x32x16_bf16(vf, pb[0][st], o[dt][0], 0, 0, 0);
                    o[dt][1] = __builtin_amdgcn_mfma_f32_32x32x16_bf16(vf, pb[1][st], o[dt][1], 0, 0, 0);
                }
        }
        if (cn < 5) lstore(buf ^ 1);
        __syncthreads();
        buf ^= 1; c = cn;
    }
    {
        LAS unsigned char* stg = lds + wid * 9216;
#pragma unroll
        for (int qt = 0; qt < 2; ++qt) {
            const float lt = lrow[qt] + __shfl_xor(lrow[qt], 32);
            const float inv = 1.0f / lt;
            LAS unsigned char* srow = stg + (qt * 32 + r32) * 144 + 8 * hi;
#pragma unroll
            for (int dt = 0; dt < 2; ++dt)
#pragma unroll
                for (int g = 0; g < 4; ++g) {
                    u32x2 w; w.x = cvt_pk_bf16(o[dt][qt][4 * g] * inv, o[dt][qt][4 * g + 1] * inv); w.y = cvt_pk_bf16(o[dt][qt][4 * g + 2] * inv, o[dt][qt][4 * g + 3] * inv);
                    *(LAS u32x2*)(srow + dt * 64 + 16 * g) = w;
                }
        }
        asm volatile("s_waitcnt lgkmcnt(0)" ::: "memory");
        bf16_t* obase = A.MIX + (qrow0 + qloc) * 1024 + 512 + hq * 64;
#pragma unroll
        for (int i = 0; i < 8; ++i) { const int row = i * 8 + (lane >> 3), ch = lane & 7;
            const u32x4 v = *(const LAS u32x4*)(stg + row * 144 + ch * 16);
            *(u32x4*)(obase + (size_t)row * 1024 + ch * 8) = v; }
    }
    __syncthreads();
}
}


#define XB_TMO      128
#define XB_XCNT(j)  (256  + 64 * (j))
#define XB_XSUB(j)  (1280 + 64 * (j))
#define XB_XGEN(j)  (2304 + 64 * (j))
#define XB_TOP      3328
#define XB_TOPGEN   3392
#define XCD_BAR_WORDS 3456
#define XB_SPIN_CAP (1u << 18)
__device__ __forceinline__ unsigned xb_ld(unsigned* p)              { return __hip_atomic_load(p, __ATOMIC_RELAXED, __HIP_MEMORY_SCOPE_AGENT); }
__device__ __forceinline__ unsigned xb_add(unsigned* p, unsigned v) { return __hip_atomic_fetch_add(p, v, __ATOMIC_RELAXED, __HIP_MEMORY_SCOPE_AGENT); }
__device__ __forceinline__ unsigned xb_xcc_id() { return (unsigned)__builtin_amdgcn_s_getreg((3 << 11) | 20) & 0xFu; }
#define XB_SPIN(cond, bar) do { unsigned _sp = 0; while (cond) { __builtin_amdgcn_s_sleep(1); \
    if ((++_sp & 255u) == 0u) { if (xb_ld(&(bar)[XB_TMO])) break; if (_sp > XB_SPIN_CAP) { atomicAdd(&(bar)[XB_TMO], 1u); break; } } } } while (0)
struct XcdBarrier { unsigned* bar; unsigned x; volatile LAS unsigned* st; };
__device__ __forceinline__ XcdBarrier xcd_barrier_post(unsigned* bar, volatile LAS unsigned* st) {
    XcdBarrier b; b.bar = bar; b.x = xb_xcc_id(); b.st = st;
    if (threadIdx.x == 0) (void)xb_add(&bar[XB_XCNT(b.x)], 1u);
    return b;
}
__device__ __forceinline__ void xcd_barrier_complete(unsigned* bar, unsigned x, unsigned& nloc, unsigned& nx) {
    const unsigned G = gridDim.x * gridDim.y * gridDim.z;
    unsigned sum, cnt, mine, sp = 0u;
    for (;;) {
        sum = 0u; cnt = 0u; mine = 0u;
#pragma unroll
        for (unsigned j = 0; j < 16; ++j) { const unsigned c = xb_ld(&bar[XB_XCNT(j)]); sum += c; cnt += (c > 0u) ? 1u : 0u; mine = (j == x) ? c : mine; }
        if (sum == G) break;
        __builtin_amdgcn_s_sleep(1);
        if ((++sp & 255u) == 0u) { if (xb_ld(&bar[XB_TMO])) break; if (sp > XB_SPIN_CAP) { atomicAdd(&bar[XB_TMO], 1u); break; } }
    }
    nloc = mine > 0u ? mine : 1u; nx = cnt > 0u ? cnt : 1u;
}
__device__ __forceinline__ void xcd_barrier(const XcdBarrier& b) {
    asm volatile("s_waitcnt vmcnt(0)" ::: "memory");
    __syncthreads();
    if (threadIdx.x == 0) {
        unsigned* bar = b.bar;
        __builtin_amdgcn_s_waitcnt(0);
        unsigned nloc = b.st[0], nx = b.st[1];
        if (nloc == 0u) { xcd_barrier_complete(bar, b.x, nloc, nx); b.st[0] = nloc; b.st[1] = nx; }
        const unsigned old = xb_add(&bar[XB_XSUB(b.x)], 1u);
        const unsigned gen = old / nloc;
        if (old + 1u == (gen + 1u) * nloc) {
            __builtin_amdgcn_fence(__ATOMIC_RELEASE, "agent");
            asm volatile("s_waitcnt vmcnt(0)" ::: "memory");
            const unsigned og = xb_add(&bar[XB_TOP], 1u);
            const unsigned tg = og / nx;
            if (og + 1u == (tg + 1u) * nx) xb_add(&bar[XB_TOPGEN], 1u);
            else XB_SPIN(xb_ld(&bar[XB_TOPGEN]) == tg, bar);
            __builtin_amdgcn_fence(__ATOMIC_ACQUIRE, "agent");
            xb_add(&bar[XB_XGEN(b.x)], 1u);
            asm volatile("s_waitcnt vmcnt(0)" ::: "memory");
        } else {
            XB_SPIN(xb_ld(&bar[XB_XGEN(b.x)]) == gen, bar);
            __builtin_amdgcn_fence(__ATOMIC_ACQUIRE, "agent");
            asm volatile("s_waitcnt vmcnt(0)" ::: "memory");
        }
    }
    __syncthreads();
}

struct Params {
    const float *x, *c, *ctx, *c_ctx, *ada_w, *ada_b, *norm_mix_g, *norm_ffn_g, *mix_in_w, *mix_out_w, *attn_sink, *pool_w, *pool_scale, *ffn_w1, *ffn_w3, *ffn_w2, *final_g;
    float* out; unsigned char* ws;
};

__device__ __forceinline__ void tr_item(const float* W, int spitch, int ncols, bf16_t* WT, int dpitch, int mode, int roff, const float* nscale, LAS float* scr, int item, int lane) {
    const int nblk = ncols / 32, kb = item / nblk, nb = item % nblk, k0 = 64 * kb, n0 = 32 * nb;
    float tv[32];
#pragma unroll
    for (int i = 0; i < 32; ++i) tv[i] = W[(size_t)(k0 + 2 * i + (lane >> 5)) * spitch + n0 + (lane & 31)];
#pragma unroll
    for (int i = 0; i < 32; ++i) scr[(2 * i + (lane >> 5)) * 33 + (lane & 31)] = tv[i];
    asm volatile("s_waitcnt lgkmcnt(0)" ::: "memory");
    const int c = lane & 7;
#pragma unroll
    for (int j = 0; j < 4; ++j) { const int n = (lane >> 3) + 8 * j; const LAS float* s = scr + (8 * c) * 33 + n;
        const float sc = nscale ? nscale[n0 + n] : 1.0f;
        const int gn = n0 + n; const int drow = (mode == 0) ? (roff + gn) : ((gn >> 7) * 256 + (gn & 127) + roff);
        u32x4 o; o.x = cvt_pk_bf16(s[0 * 33] * sc, s[1 * 33] * sc); o.y = cvt_pk_bf16(s[2 * 33] * sc, s[3 * 33] * sc); o.z = cvt_pk_bf16(s[4 * 33] * sc, s[5 * 33] * sc); o.w = cvt_pk_bf16(s[6 * 33] * sc, s[7 * 33] * sc);
        *(u32x4*)(WT + (size_t)drow * dpitch + k0 + 8 * c) = o; }
    asm volatile("s_waitcnt lgkmcnt(0)" ::: "memory");
}

template <class TS>
__device__ __forceinline__ void norm_load(f32x4 (&v)[4][4], const TS* srcL, const TS* srcC, int row0, int lane) {
    const TS* src = (row0 < NLAT) ? srcL + (size_t)row0 * D : srcC + (size_t)(row0 - NLAT) * D;
#pragma unroll
    for (int r = 0; r < 4; ++r)
#pragma unroll
        for (int j = 0; j < 4; ++j) v[r][j] = ld4(src + (size_t)r * D + lane * 4 + 256 * j);
}
template <class TS>
__device__ __forceinline__ void norm_pass(const TS* srcL, const TS* srcC, const float* gvec, const float* modl, int shift_off, int scale_off, bf16_t* XN, int M, int gw, int NGW) {
    const int lane = opaque_tid() & 63;
    int row0 = gw * 4;
    if (row0 >= M) return;
    f32x4 v[4][4], vn[4][4];
    norm_load(v, srcL, srcC, row0, lane);
    for (;;) {
        const int rown = row0 + NGW * 4; const bool has_next = rown < M;
        if (has_next) norm_load(vn, srcL, srcC, rown, lane);
        const int mb = (row0 < NLAT) ? (row0 >> 12) : 8;
        float rstd[4];
#pragma unroll
        for (int r = 0; r < 4; ++r) { float ss = 0.f;
#pragma unroll
            for (int j = 0; j < 4; ++j) ss += (v[r][j].x * v[r][j].x + v[r][j].y * v[r][j].y) + (v[r][j].z * v[r][j].z + v[r][j].w * v[r][j].w);
            rstd[r] = rsqrtf(wave_sum(ss) * (1.0f / D) + EPS); }
        const float* mrow = modl + (size_t)mb * MODW;
#pragma unroll
        for (int j = 0; j < 4; ++j) { const int c = lane * 4 + 256 * j;
            const f32x4 g4 = *(const f32x4*)(gvec + c), sc4 = *(const f32x4*)(mrow + scale_off + c), sh4 = *(const f32x4*)(mrow + shift_off + c);
            const f32x4 G4 = g4 * (sc4 + 1.0f);
#pragma unroll
            for (int r = 0; r < 4; ++r) { const f32x4 q = v[r][j] * rstd[r] * G4 + sh4;
                u32x2 w; w.x = cvt_pk_bf16(q.x, q.y); w.y = cvt_pk_bf16(q.z, q.w);
                ((u32x2*)(XN + (size_t)(row0 + r) * D) + lane)[64 * j] = w; } }
        if (!has_next) break;
#pragma unroll
        for (int r = 0; r < 4; ++r)
#pragma unroll
            for (int j = 0; j < 4; ++j) v[r][j] = vn[r][j];
        row0 = rown;
    }
}

template <int HALF>
__device__ __forceinline__ void pool_rows(const f32x2 (&v)[47], f32x2 G2, int t0, int N, bf16_t* po) {
    f32x2 S = (f32x2){0.f, 0.f};
#pragma unroll
    for (int i = 8 - HALF; i < 8 + HALF; ++i) S += v[i];
#pragma unroll
    for (int t = 0; t < 32; ++t) {
        const int tt = t0 + t;
        const int lo = (tt - HALF) > 0 ? (tt - HALF) : 0, hh = (tt + HALF) < N ? (tt + HALF) : N;
        const float icnt = 1.0f / (float)(hh - lo);
        const f32x2 r = G2 * (S * icnt - v[t + 8]);
        *(unsigned*)(po + (size_t)t * D) = cvt_pk_bf16(r.x, r.y);
        if (t < 31) S += v[t + 8 + HALF] - v[t + 8 - HALF];
    }
}
struct PoolItem { int t0, N, mb; const bf16_t* base; size_t orow0; };
__device__ __forceinline__ PoolItem pool_item(int item, const bf16_t* srcL, const bf16_t* srcC) {
    PoolItem q;
    if (item < 1024) { const int seq = item >> 7; q.t0 = (item & 127) * 32; q.N = SEQ; q.base = srcL + (size_t)seq * SEQ * D; q.mb = seq; q.orow0 = (size_t)seq * SEQ; }
    else { const int it = item - 1024; const int seq = it >> 3; q.t0 = (it & 7) * 32; q.N = CTX; q.base = srcC + (size_t)seq * CTX * D; q.mb = 8; q.orow0 = (size_t)NLAT + seq * CTX; }
    return q;
}
__device__ __forceinline__ void pool_load(f32x2 (&v)[47], const PoolItem& q, int c0) {
    const bf16_t* colp = q.base + c0;
#pragma unroll
    for (int i = 0; i < 47; ++i) { const int t = q.t0 - 8 + i; v[i] = (t >= 0 && t < q.N) ? ld2(colp + (size_t)t * D) : (f32x2){0.f, 0.f}; }
}
__device__ __forceinline__ void pool_pass(const bf16_t* srcL, const bf16_t* srcC, const float* gvec, const float* modl, int scale_off, bf16_t* PO, bool with_ctx, LAS float* lds_f, int G) {
    const int tid = opaque_tid(), lane = tid & 63, wave = tid >> 6;
    LAS float* part = lds_f;
    LAS float* srs = lds_f + 8 * 48;
    const int nitems = 1024 + (with_ctx ? 64 : 0);
    int q = 0; while ((q + 1) * G <= nitems) ++q;
    const int rem = nitems - q * G, bxi = (int)blockIdx.x;
    const int i0 = bxi * q + (bxi < rem ? bxi : rem), i1 = i0 + q + (bxi < rem ? 1 : 0);
    const int c0 = 2 * tid;
    const int grp = c0 >> 8;
    const f32x2 g2 = *(const f32x2*)(gvec + c0);
    if (i0 >= i1) return;
    f32x2 v[47], vn[47];
    PoolItem cur = pool_item(i0, srcL, srcC);
    pool_load(v, cur, c0);
    for (int item = i0; item < i1; ++item) {
        PoolItem nxt = cur;
        const bool has_next = item + 1 < i1;
        if (has_next) { nxt = pool_item(item + 1, srcL, srcC); pool_load(vn, nxt, c0); }
#pragma unroll
        for (int i = 0; i < 47; ++i) { const float s = wave_sum(v[i].x * v[i].x + v[i].y * v[i].y); if (lane == 0) part[wave * 48 + i] = s; }
        __syncthreads();
        if (tid < 47) { float s = 0.f;
#pragma unroll
            for (int w = 0; w < 8; ++w) s += part[w * 48 + tid];
            srs[tid] = rsqrtf(s * (1.0f / D) + EPS); }
        __syncthreads();
#pragma unroll
        for (int i = 0; i < 47; ++i) v[i] = v[i] * srs[i];
        const f32x2 sc2 = *(const f32x2*)(modl + (size_t)cur.mb * MODW + scale_off + c0);
        const f32x2 G2 = g2 * (sc2 + 1.0f);
        bf16_t* po = PO + (cur.orow0 + cur.t0) * D + c0;
        if (grp == 0) pool_rows<1>(v, G2, cur.t0, cur.N, po);
        else if (grp == 1) pool_rows<2>(v, G2, cur.t0, cur.N, po);
        else if (grp == 2) pool_rows<4>(v, G2, cur.t0, cur.N, po);
        else pool_rows<8>(v, G2, cur.t0, cur.N, po);
        __syncthreads();
        if (has_next) {
#pragma unroll
            for (int i = 0; i < 47; ++i) v[i] = vn[i];
            cur = nxt; }
    }
}

__device__ __forceinline__ float bf2f(unsigned short h) { return __uint_as_float((unsigned)h << 16); }
__device__ __forceinline__ void fold_pass(const bf16_t* FT, bf16_t* FTF, int gw, int NGW) {
    const int lane = opaque_tid() & 63;
    for (int r = gw; r < 4096; r += NGW) {
        const bf16_t* a = FT + (size_t)r * 8192; bf16_t* o = FTF + (size_t)r * 4096;
        bf16x8 lo[2][4], mi[2][4]; unsigned short m0[2][4];
        const unsigned short a2048 = a[2048];
#pragma unroll
        for (int part = 0; part < 2; ++part)
#pragma unroll
            for (int j = 0; j < 4; ++j) { const bf16_t* s = a + part * 4096; const int n0 = 8 * (lane + 64 * j);
                lo[part][j] = *(const bf16x8*)(s + n0);
                mi[part][j] = *(const bf16x8*)(s + 4096 - n0 - 8);
                m0[part][j] = s[(n0 > 0) ? (4096 - n0) : 0]; }
        asm volatile("" ::: "memory");
#pragma unroll
        for (int part = 0; part < 2; ++part) { const float sg = part ? -1.0f : 1.0f;
#pragma unroll
            for (int j = 0; j < 4; ++j) { const int n0 = 8 * (lane + 64 * j);
                float v[8];
                v[0] = bf2f((unsigned short)lo[part][j][0]) + sg * bf2f(m0[part][j]);
#pragma unroll
                for (int e = 1; e < 8; ++e) v[e] = bf2f((unsigned short)lo[part][j][e]) + sg * bf2f((unsigned short)mi[part][j][8 - e]);
                if (n0 == 0) v[0] = part ? bf2f(a2048) : bf2f((unsigned short)lo[part][j][0]);
                u32x4 w; w.x = cvt_pk_bf16(v[0], v[1]); w.y = cvt_pk_bf16(v[2], v[3]); w.z = cvt_pk_bf16(v[4], v[5]); w.w = cvt_pk_bf16(v[6], v[7]);
                *(u32x4*)(o + part * 2048 + n0) = w; } }
    }
}

__device__ __forceinline__ void ffn_weights_convert(const Params& p, bf16_t* W13, bf16_t* W2, int l_lo, int l_hi, int widx, int nw, LAS float* scr) {
    const int lane = opaque_tid() & 63;
    constexpr int I_W = 16 * 88, I_2 = 44 * 32, I_L = 2 * I_W + I_2;
    const int n = (l_hi - l_lo) * I_L;
    for (int it = widx; it < n; it += nw) {
        const int l = l_lo + it / I_L; const int r = it % I_L;
        if (r < I_W) tr_item(p.ffn_w1 + (size_t)l * D * FF, FF, FF, W13 + (size_t)l * W13_L, D, 1, 0, nullptr, scr, r, lane);
        else if (r < 2 * I_W) tr_item(p.ffn_w3 + (size_t)l * D * FF, FF, FF, W13 + (size_t)l * W13_L, D, 1, 128, nullptr, scr, r - I_W, lane);
        else tr_item(p.ffn_w2 + (size_t)l * FF * D, D, D, W2 + (size_t)l * W2_L, FF, 0, 0, nullptr, scr, r - 2 * I_W, lane);
    }
}

__global__ void __launch_bounds__(512, 2) fwd_kernel(Params p) {
    extern __shared__ __attribute__((aligned(16))) unsigned char lds_raw[];
    LAS unsigned char* lds = (LAS unsigned char*)lds_raw;
    cg::grid_group grid = cg::this_grid();
    const int tid = threadIdx.x, lane = tid & 63, wave = __builtin_amdgcn_readfirstlane(tid >> 6);
    const int G = gridDim.x, bx = blockIdx.x;
    const int vcu = (G % 8 == 0) ? (bx % 8) * (G / 8) + bx / 8 : bx;
    const int gw = vcu * 8 + wave, NGW = G * 8;
    const int gtid = bx * 512 + tid, NT = G * 512;
    unsigned char* ws = p.ws;
    volatile LAS unsigned* bst = (volatile LAS unsigned*)(lds + 131072 + 1024);
    if (tid < 2) bst[tid] = 0u;
    __syncthreads();
    XcdBarrier xbar = xcd_barrier_post((unsigned*)(ws + WS_BAR), bst);
    float* MOD = (float*)(ws + WS_MOD); float* ROPE = (float*)(ws + WS_ROPE); bf16_t* DFT256 = (bf16_t*)(ws + WS_DFT256); bf16_t* HC = (bf16_t*)(ws + WS_HC); bf16_t* HB = (bf16_t*)(ws + WS_HB);
    bf16_t* DFT = (bf16_t*)(ws + WS_DFT); bf16_t* XN = (bf16_t*)(ws + WS_XN);
    bf16_t* W13 = (bf16_t*)(ws + WS_W13); bf16_t* W2 = (bf16_t*)(ws + WS_W2); bf16_t* WQKV = (bf16_t*)(ws + WS_WQKV); bf16_t* WF = (bf16_t*)(ws + WS_WF); bf16_t* WO = (bf16_t*)(ws + WS_WO); bf16_t* WP = (bf16_t*)(ws + WS_WP);
    bf16_t* U = (bf16_t*)(ws + WS_U); bf16_t* Qb = (bf16_t*)(ws + WS_Q); bf16_t* Kb = (bf16_t*)(ws + WS_K);
    bf16_t* FTF = (bf16_t*)(ws + WS_FTF); bf16_t* FT = (bf16_t*)(ws + WS_FT); bf16_t* FTc = (bf16_t*)(ws + WS_FTC); bf16_t* MIX = (bf16_t*)(ws + WS_MIX);

    {
        LAS float* sS = (LAS float*)lds;
        LAS float* sR = (LAS float*)(lds + 9 * 1024 * 4);
        for (int idx = tid; idx < 9 * 1024; idx += 512) { const int r = idx >> 10, k = idx & 1023; const float v = r < 8 ? p.c[r * 1024 + k] : p.c_ctx[k]; sS[idx] = v / (1.0f + __expf(-v)); }
        __syncthreads();
        for (int item = bx; item < 4 * 96; item += G) {
            const int layer = item / 96, j0 = (item % 96) * 64;
            const float* W = p.ada_w + (size_t)layer * D * MODW + j0 + lane;
            float a0 = 0.f, a1 = 0.f, a2 = 0.f, a3 = 0.f, a4 = 0.f, a5 = 0.f, a6 = 0.f, a7 = 0.f, a8 = 0.f;
#pragma unroll 1
            for (int kb = 0; kb < 128; kb += 32) {
                float wv[32];
#pragma unroll
                for (int e = 0; e < 32; ++e) wv[e] = W[(size_t)(wave * 128 + kb + e) * MODW];
#pragma unroll
                for (int e = 0; e < 32; ++e) { const int k = wave * 128 + kb + e;
                    a0 += sS[k] * wv[e]; a1 += sS[1024 + k] * wv[e]; a2 += sS[2048 + k] * wv[e]; a3 += sS[3072 + k] * wv[e]; a4 += sS[4096 + k] * wv[e];
                    a5 += sS[5120 + k] * wv[e]; a6 += sS[6144 + k] * wv[e]; a7 += sS[7168 + k] * wv[e]; a8 += sS[8192 + k] * wv[e]; } }
            LAS float* rr = sR + wave * 9 * 64 + lane;
            rr[0] = a0; rr[64] = a1; rr[128] = a2; rr[192] = a3; rr[256] = a4; rr[320] = a5; rr[384] = a6; rr[448] = a7; rr[512] = a8;
            __syncthreads();
            for (int o = tid; o < 576; o += 512) { const int r = o >> 6, l = o & 63; float s = 0.f;
#pragma unroll
                for (int w = 0; w < 8; ++w) s += sR[(w * 9 + r) * 64 + l];
                MOD[((size_t)layer * 9 + r) * MODW + j0 + l] = s + p.ada_b[(size_t)layer * MODW + j0 + l]; }
            __syncthreads();
        }
        {
            LAS float* wt = (LAS float*)lds;
            LAS float* tc = (LAS float*)(lds + 32 * 129 * 4);
            for (int item = bx; item < 256; item += G) {
                const int j = item >> 7, h = (item >> 5) & 3, k0 = (item & 31) * 32;
                __syncthreads();
                if (tid < 128) { const float t = (float)tid * (1.0f / 128.0f); tc[tid] = __builtin_amdgcn_cosf(t); tc[128 + tid] = __builtin_amdgcn_sinf(t); }
                for (int idx = tid; idx < 32 * 128; idx += 512) { const int kk = idx >> 7, i = idx & 127; wt[kk * 129 + i] = p.mix_in_w[((size_t)j * D + k0 + kk) * 1280 + h * 128 + i]; }
                __syncthreads();
                const int jj = tid & 127, kq = tid >> 7;
                float ac[8], as[8];
#pragma unroll
                for (int e = 0; e < 8; ++e) { ac[e] = 0.f; as[e] = 0.f; }
                for (int i = 0; i < 128; ++i) { const int ph = (i * jj) & 127; const float cv = tc[ph], sv = tc[128 + ph];
#pragma unroll
                    for (int e = 0; e < 8; ++e) { const float w = wt[(kq * 8 + e) * 129 + i]; ac[e] += w * cv; as[e] += w * sv; } }
                const float nrm = 0.08838834764831845f;
                u32x4 oc, os;
                oc.x = cvt_pk_bf16(ac[0] * nrm, ac[1] * nrm); oc.y = cvt_pk_bf16(ac[2] * nrm, ac[3] * nrm); oc.z = cvt_pk_bf16(ac[4] * nrm, ac[5] * nrm); oc.w = cvt_pk_bf16(ac[6] * nrm, ac[7] * nrm);
                os.x = cvt_pk_bf16(as[0] * nrm, as[1] * nrm); os.y = cvt_pk_bf16(as[2] * nrm, as[3] * nrm); os.z = cvt_pk_bf16(as[4] * nrm, as[5] * nrm); os.w = cvt_pk_bf16(as[6] * nrm, as[7] * nrm);
                bf16_t* dst = WF + (size_t)j * WF_L + (size_t)(h * 128 + jj) * D + k0 + kq * 8;
                *(u32x4*)dst = oc; *(u32x4*)(dst + (size_t)512 * D) = os;
            }
            __syncthreads();
        }
        {
            LAS float* scr = (LAS float*)(lds + wave * 8448);
            constexpr int I_QKV = 16 * 24, I_O = 16 * 32, I_E = I_QKV + I_O, I_P = 4 * 32;
            constexpr int NITEMS = 2 * I_E + 2 * I_P;
            ffn_weights_convert(p, W13, W2, 0, 1, gw, NGW, scr);
            for (int it = gw; it < NITEMS; it += NGW) {
                int r = it;
                if (r < 2 * I_E) { const int j = r / I_E; r -= j * I_E;
                    if (r < I_QKV) tr_item(p.mix_in_w + (size_t)j * D * 1280 + 512, 1280, 768, WQKV + (size_t)j * WQKV_L, D, 0, 0, nullptr, scr, r, lane);
                    else tr_item(p.mix_out_w + (size_t)j * D * D, D, D, WO + (size_t)j * WO_L, D, 0, 0, nullptr, scr, r - I_QKV, lane);
                    continue; }
                r -= 2 * I_E;
                { const int j = r / I_P; r -= j * I_P; const int gq = r / 32; r -= gq * 32;
                  tr_item(p.pool_w + ((size_t)j * 4 + gq) * 65536, 256, 256, WP + (size_t)j * WP_L + (size_t)gq * 65536, 256, 0, 0, p.pool_scale + (size_t)j * D + gq * 256, scr, r, lane); }
            }
        }
        for (int idx = gtid; idx < 4096 * 512; idx += NT) {
            const int k = idx >> 9, n0 = (idx & 511) * 8;
            float v[8];
#pragma unroll
            for (int e = 0; e < 8; ++e) { const int np = n0 + e; float r;
                if (np < 2048) r = __builtin_amdgcn_cosf((float)((k * np) & 4095) * (1.0f / 4096.0f));
                else if (np == 2048) r = (k & 1) ? -1.0f : 1.0f;
                else r = -__builtin_amdgcn_sinf((float)((k * (np - 2048)) & 4095) * (1.0f / 4096.0f));
                v[e] = r * (1.0f / 64.0f); }
            u32x4 o; o.x = cvt_pk_bf16(v[0], v[1]); o.y = cvt_pk_bf16(v[2], v[3]); o.z = cvt_pk_bf16(v[4], v[5]); o.w = cvt_pk_bf16(v[6], v[7]);
            *(u32x4*)(DFT + (size_t)k * 4096 + n0) = o;
        }
        for (int idx = gtid; idx < 256 * 64; idx += NT) {
            const int k = idx >> 6, n0 = (idx & 63) * 8; const bool sp = n0 >= 256; const int nn = n0 & 255;
            float v[8];
#pragma unroll
            for (int e = 0; e < 8; ++e) { const float t = (float)((k * (nn + e)) & 255) * (1.0f / 256.0f); v[e] = (sp ? -__builtin_amdgcn_sinf(t) : __builtin_amdgcn_cosf(t)) * (1.0f / 16.0f); }
            u32x4 o; o.x = cvt_pk_bf16(v[0], v[1]); o.y = cvt_pk_bf16(v[2], v[3]); o.z = cvt_pk_bf16(v[4], v[5]); o.w = cvt_pk_bf16(v[6], v[7]);
            *(u32x4*)(DFT256 + (size_t)k * 512 + n0) = o;
        }
        for (int idx = gtid; idx < 64 * 16; idx += NT) {
            const int pos = idx >> 4, f = idx & 15;
            const float inv = exp2f(-(float)f * (13.287712379549449f / 16.0f));
            const float turns = (float)pos * inv * 0.15915494309189535f;
            const float fr = turns - floorf(turns);
            ROPE[2 * idx] = __builtin_amdgcn_cosf(fr); ROPE[2 * idx + 1] = __builtin_amdgcn_sinf(fr);
        }
    }
    grid.sync();

    for (int layer = 0; layer < DEPTH; ++layer) {
        const float* modl = MOD + (size_t)layer * 9 * MODW;
        const int jj = layer >> 1;
        const bool upd_ctx = layer < 2;
        if ((layer & 1) == 0) {
            const int Mrows = MALL;
            if (layer == 0) norm_pass(p.x, p.ctx, p.norm_mix_g + (size_t)layer * D, modl, 0, D, XN, Mrows, gw, NGW);
            else norm_pass(HB, HC, p.norm_mix_g + (size_t)layer * D, modl, 0, D, XN, Mrows, gw, NGW);
            xcd_barrier(xbar);
            { pg8::Gemm g{XN, WQKV + (size_t)jj * WQKV_L, D, D, D, 0, 0}; pg8::Order S(Mrows / 256, 3, 1, G, vcu, 3);
              pg8::EpiQKV E{Qb, Kb, ROPE}; pg8::gemm_phase(lds, g, S, E); }
            { const int ntok = upd_ctx ? MALL : NLAT;
              pg8::Gemm g{WF + (size_t)jj * WF_L, XN, D, D, D, 0, 0}; pg8::Order S(4, ntok / 256, 1, G, G - 1 - vcu, 2);
              pg8::EpiFT E{FT, FTc}; pg8::gemm_phase(lds, g, S, E); }
            xcd_barrier(xbar);
            if (upd_ctx && G > 32) { if (vcu >= 32) fold_pass(FT, FTF, (vcu - 32) * 8 + wave, (G - 32) * 8); }
            else fold_pass(FT, FTF, gw, NGW);
            { att::Args A{Qb, Kb, MIX, p.attn_sink + jj * 8};
              const int nun = 512 + (upd_ctx ? 32 : 0);
              for (int un = vcu; un < nun; un += G) {
                  int b, blk, kvh;
                  if (un < 512) { b = un >> 6; blk = (un >> 1) & 31; kvh = un & 1; } else { const int q = un - 512; b = q >> 2; blk = 32 + ((q >> 1) & 1); kvh = q & 1; }
                  att::unit(lds, A, b, blk, kvh);
              } }
            xcd_barrier(xbar);
            { pg8::Gemm g{DFT, FTF, 4096, 4096, 4096, 0, (long)512 * 4096}; pg8::Order S(16, 2, 8, G, vcu, 3);
              pg8::EpiStore E{MIX, 1024, (long)SEQ * 1024}; pg8::gemm_phase(lds, g, S, E); }
            if (upd_ctx) { pg8::Gemm g{DFT256, FTc, 512, 512, 512, 0, (long)512 * 512}; pg8::Order S(1, 2, 8, G, vcu, 0);
              pg8::EpiStore E{MIX + (size_t)NLAT * 1024, 1024, (long)CTX * 1024}; pg8::gemm_phase(lds, g, S, E); }
            xcd_barrier(xbar);
            { const int Mo = upd_ctx ? MALL : NLAT;
              pg8::Gemm g{MIX, WO + (size_t)jj * WO_L, D, D, D, 0, 0}; pg8::Order S(Mo / 256, 4, 1, G, vcu, 3);
              if (layer == 0) { pg8::EpiResH<float> E{p.x, p.ctx, HB, HC, modl + 2 * D, 0}; pg8::gemm_phase(lds, g, S, E); }
              else { pg8::EpiResH<bf16_t> E{HB, HC, HB, HC, modl + 2 * D, 0}; pg8::gemm_phase(lds, g, S, E); } }
            xcd_barrier(xbar);
        } else {
            pool_pass(HB, HC, p.norm_mix_g + (size_t)layer * D, modl, D, MIX, upd_ctx, (LAS float*)lds, G);
            xcd_barrier(xbar);
            { const int Mo = upd_ctx ? MALL : NLAT;
              pg8::Gemm g{MIX, WP + (size_t)jj * WP_L, 256, D, 256, 256, 65536}; pg8::Order S(Mo / 256, 1, 4, G, vcu, 3, 1);
              pg8::EpiResH<bf16_t> E{HB, HC, HB, HC, modl + 2 * D, 256}; pg8::gemm_phase(lds, g, S, E); }
            xcd_barrier(xbar);
        }
        const int Mf = upd_ctx ? MALL : NLAT;
        norm_pass(HB, HC, p.norm_ffn_g + (size_t)layer * D, modl, 3 * D, 4 * D, XN, Mf, gw, NGW);
        xcd_barrier(xbar);
        { pg8::Gemm g{XN, W13 + (size_t)layer * W13_L, D, D, D, 0, 0}; pg8::Order S(Mf / 256, 22, 1, G, vcu, 3);
          pg8::EpiSwiGLU E{U}; pg8::gemm_phase(lds, g, S, E); }
        xcd_barrier(xbar);
        { pg8::Gemm g{U, W2 + (size_t)layer * W2_L, FF, FF, FF, 0, 0}; pg8::Order S(NLAT / 256, 4, 1, G, vcu, 3);
          pg8::EpiResH<bf16_t> E{HB, HC, HB, HC, modl + 5 * D, 0}; pg8::gemm_phase(lds, g, S, E); }
        if (upd_ctx) {
            float* SL = (float*)(ws + WS_SLAB);
            { pg8::Gemm g{U + (size_t)NLAT * FF, W2 + (size_t)layer * W2_L, FF / 2, FF, FF, FF / 2, FF / 2}; pg8::Order S(NCTX / 256, 4, 2, G, vcu, 3);
              pg8::EpiPartial E{SL, (long)NCTX * D}; pg8::gemm_phase(lds, g, S, E); }
            { const int cb = (G > 64) ? 64 : 0;
              if (vcu >= cb) ffn_weights_convert(p, W13, W2, layer == 0 ? 1 : 2, layer == 0 ? 2 : 4, (vcu - cb) * 8 + wave, (G - cb) * 8, (LAS float*)(lds + wave * 8448)); }
            xcd_barrier(xbar);
            { const int lane_c = opaque_tid() & 63; const float* g2 = modl + (size_t)8 * MODW + 5 * D;
              for (int row = gw; row < NCTX; row += NGW) {
                  bf16_t* hr = HC + (size_t)row * D + lane_c * 4; const f32x4* s0 = (const f32x4*)(SL + (size_t)row * D) + lane_c; const f32x4* s1 = s0 + (size_t)NCTX * D / 4;
                  f32x4 hv[4], sa[4], sb[4];
#pragma unroll
                  for (int j = 0; j < 4; ++j) { hv[j] = ld4(hr + 256 * j); sa[j] = s0[64 * j]; sb[j] = s1[64 * j]; }
                  asm volatile("" ::: "memory");
#pragma unroll
                  for (int j = 0; j < 4; ++j) { const f32x4 o = hv[j] + *(const f32x4*)(g2 + lane_c * 4 + 256 * j) * (sa[j] + sb[j]);
                      u32x2 w; w.x = cvt_pk_bf16(o.x, o.y); w.y = cvt_pk_bf16(o.z, o.w); *(u32x2*)(hr + 256 * j) = w; } } }
        }
        xcd_barrier(xbar);
    }
    { const int lane_f = opaque_tid() & 63;
      f32x4 g4[4];
#pragma unroll
      for (int j = 0; j < 4; ++j) g4[j] = *(const f32x4*)(p.final_g + lane_f * 4 + 256 * j);
      for (int row0 = gw * 4; row0 < NLAT; row0 += NGW * 4) {
        f32x4* xr = (f32x4*)(p.out + (size_t)row0 * D) + lane_f;
        f32x4 v[4][4];
#pragma unroll
        for (int r = 0; r < 4; ++r)
#pragma unroll
            for (int j = 0; j < 4; ++j) v[r][j] = ld4(HB + (size_t)(row0 + r) * D + lane_f * 4 + 256 * j);
#pragma unroll
        for (int r = 0; r < 4; ++r) { float ss = 0.f;
#pragma unroll
            for (int j = 0; j < 4; ++j) ss += (v[r][j].x * v[r][j].x + v[r][j].y * v[r][j].y) + (v[r][j].z * v[r][j].z + v[r][j].w * v[r][j].w);
            const float rstd = rsqrtf(wave_sum(ss) * (1.0f / D) + EPS);
#pragma unroll
            for (int j = 0; j < 4; ++j) xr[r * (D / 4) + 64 * j] = v[r][j] * rstd * g4[j]; }
      } }
}

extern "C" void kernel_launch(void* const* d_in, const int* in_sizes, int n_in, void* d_out, int out_size, void* d_ws, size_t ws_size, hipStream_t stream) {
    static int grid_blocks = 0;
    if (grid_blocks == 0) {
        if (n_in != 17 || ws_size < WS_END) { fprintf(stderr, "kernel_launch: unexpected inputs (n_in %d, ws %zu)\n", n_in, ws_size); grid_blocks = -1; return; }
        int dev = 0, cus = 0, per_cu = 0;
        hipGetDevice(&dev);
        hipDeviceGetAttribute(&cus, hipDeviceAttributeMultiprocessorCount, dev);
        hipFuncSetAttribute((const void*)fwd_kernel, hipFuncAttributeMaxDynamicSharedMemorySize, LDS_BYTES);
        hipOccupancyMaxActiveBlocksPerMultiprocessor(&per_cu, (const void*)fwd_kernel, 512, LDS_BYTES);
        if (per_cu < 1) { fprintf(stderr, "kernel_launch: occupancy query gave %d\n", per_cu); per_cu = 1; }
        (void)hipGetLastError();
        grid_blocks = cus;
    }
    if (grid_blocks < 0) return;
    (void)hipMemsetAsync((unsigned char*)d_ws + WS_BAR, 0, BAR_BYTES, stream);
    Params p{};
    const float** pf = (const float**)&p;
    for (int i = 0; i < 17; ++i) pf[i] = (const float*)d_in[i];
    p.out = (float*)d_out; p.ws = (unsigned char*)d_ws;
    void* args[] = {&p};
    hipError_t e = hipLaunchCooperativeKernel((const void*)fwd_kernel, dim3(grid_blocks), dim3(512), args, LDS_BYTES, stream);
    if (e != hipSuccess) fprintf(stderr, "cooperative launch failed: %s (grid %d)\n", hipGetErrorString(e), grid_blocks);
}
```

```cpp
#include <hip/hip_runtime.h>
#include <hip/hip_cooperative_groups.h>
#include <cstdio>
#include <cstdint>
namespace cg = cooperative_groups;

#define LAS __attribute__((address_space(3)))
typedef unsigned short bf16_t;
typedef short bf16x8 __attribute__((ext_vector_type(8)));
typedef short s16x4 __attribute__((ext_vector_type(4)));
typedef float f32x4 __attribute__((ext_vector_type(4)));
typedef float f32x2 __attribute__((ext_vector_type(2)));
typedef float f32x16 __attribute__((ext_vector_type(16)));
typedef unsigned u32x4 __attribute__((ext_vector_type(4)));
typedef unsigned u32x2 __attribute__((ext_vector_type(2)));

constexpr int D = 1024, NB = 8, SEQ = 4096, NLAT = NB * SEQ, CTX = 256, NCTX = NB * CTX, MALL = NLAT + NCTX, FF = 2816, DEPTH = 4;
constexpr int MODW = 6 * D;
constexpr float EPS = 1e-6f;
constexpr float QSCALE = 0.125f * 1.4426950408889634f;
constexpr float LOG2E = 1.4426950408889634f;

constexpr size_t MiB = 1u << 20;
constexpr size_t WS_MOD = 0, WS_ROPE = 1 * MiB, WS_DFT256 = 2 * MiB, WS_HC = 3 * MiB, WS_HB = 11 * MiB, WS_XN = 75 * MiB;
constexpr size_t WS_W13 = 143 * MiB, WS_W2 = 187 * MiB, WS_WQKV = 209 * MiB, WS_WF = 212 * MiB, WS_WO = 216 * MiB, WS_WP = 220 * MiB;
constexpr size_t WS_U = 221 * MiB;
constexpr size_t WS_Q = 221 * MiB, WS_K = 255 * MiB, WS_VT = 264 * MiB, WS_VTC = 272 * MiB, WS_FT = 273 * MiB, WS_FTC = 337 * MiB, WS_MIX = 341 * MiB;
constexpr size_t WS_FTF = 410 * MiB;
constexpr size_t WS_SLAB = 442 * MiB;
constexpr size_t WS_DFT = 458 * MiB;
constexpr size_t WS_END = 490 * MiB;
constexpr size_t WS_BAR = 1 * MiB + 512 * 1024, BAR_BYTES = 16384;
constexpr size_t W13_L = (size_t)2 * FF * D, W2_L = (size_t)D * FF, WQKV_L = (size_t)768 * D, WF_L = (size_t)1024 * D, WO_L = (size_t)D * D, WP_L = (size_t)4 * 256 * 256;

constexpr int LDS_BYTES = 147456;

__device__ __forceinline__ unsigned cvt_pk_bf16(float lo, float hi) { unsigned r; asm volatile("v_cvt_pk_bf16_f32 %0, %1, %2" : "=v"(r) : "v"(lo), "v"(hi)); return r; }
__device__ __forceinline__ float wave_sum(float v) {
#pragma unroll
    for (int o = 1; o < 64; o <<= 1) v += __shfl_xor(v, o);
    return v;
}
__device__ __forceinline__ int opaque_tid() { int t = threadIdx.x; asm volatile("" : "+v"(t)); return t; }
__device__ __forceinline__ f32x4 ld4(const float* p) { return *(const f32x4*)p; }
__device__ __forceinline__ f32x4 ld4(const bf16_t* p) { const u32x2 w = *(const u32x2*)p; return (f32x4){__uint_as_float(w.x << 16), __uint_as_float(w.x & 0xffff0000u), __uint_as_float(w.y << 16), __uint_as_float(w.y & 0xffff0000u)}; }
__device__ __forceinline__ f32x2 ld2(const float* p) { return *(const f32x2*)p; }
__device__ __forceinline__ f32x2 ld2(const bf16_t* p) { const unsigned w = *(const unsigned*)p; return (f32x2){__uint_as_float(w << 16), __uint_as_float(w & 0xffff0000u)}; }
__device__ __forceinline__ float silu_f(float x) { return x * __builtin_amdgcn_rcpf(1.0f + __expf(-x)); }
__device__ __forceinline__ void silu_mul8(f32x4 a0, f32x4 b0, f32x4 a1, f32x4 b1, f32x4& o0, f32x4& o1) {
    const f32x4 t0 = a0 * (-1.4426950408889634f), t1 = a1 * (-1.4426950408889634f);
    f32x4 e0, e1;
#pragma unroll
    for (int j = 0; j < 4; ++j) { e0[j] = __builtin_amdgcn_exp2f(t0[j]); e1[j] = __builtin_amdgcn_exp2f(t1[j]); }
    const f32x4 d0 = e0 + 1.0f, d1 = e1 + 1.0f;
    f32x4 r0, r1;
#pragma unroll
    for (int j = 0; j < 4; ++j) { r0[j] = __builtin_amdgcn_rcpf(d0[j]); r1[j] = __builtin_amdgcn_rcpf(d1[j]); }
    o0 = (a0 * b0) * r0; o1 = (a1 * b1) * r1;
}

namespace pg8 {
constexpr int BM = 256, BK = 64, HALF = 128, HTB = HALF * BK * 2, STAGE_BYTES = 8 * HTB, WGM = 8;
__device__ __forceinline__ int lds_byte(int r, int c) { const int st = (r >> 4) * 2 + (c >> 5), rr = r & 15, cc = c & 31, ob = rr * 64 + cc * 2; return st * 1024 + (ob ^ (((ob >> 9) & 1) << 5)); }
__device__ __forceinline__ void stage_rc(int b, int& R, int& C) { const int st = b / 1024, sb = b % 1024, swz = sb ^ (((sb >> 9) & 1) << 5); R = (st >> 1) * 16 + swz / 64; C = (st & 1) * 32 + (swz % 64) / 2; }
__device__ __forceinline__ int perm32(int rho) { const int n = rho >> 4, i = rho & 15; return 8 * (i >> 2) + 4 * n + (i & 3); }

struct Unit { int pm, pn, z; };
struct Gemm { const bf16_t* A; const bf16_t* Bt; int K, lda, ldb; long sA, sB; long hsA = 0, hsB = 0, tsA = 0, tsB = 0; };

struct Order {
    int nN, nZ, per, G, vcu, gsh, zfast; unsigned nig, inv;
    __device__ __forceinline__ Order(int nM_, int nN_, int nZ_, int G_, int vcu_, int gsh_, int zfast_ = 0) {
        nN = nN_; nZ = nZ_; per = nM_ * nN_; G = G_; vcu = vcu_; gsh = gsh_; zfast = zfast_; nig = (unsigned)nN_ << gsh_;
        inv = (unsigned)__builtin_amdgcn_readfirstlane((int)((1u << 24) / nig + 1u));
    }
    __device__ __forceinline__ bool next(int i, Unit& u) const {
        const unsigned L = (unsigned)i * (unsigned)G + (unsigned)vcu;
        if (L >= (unsigned)per * (unsigned)nZ) return false;
        unsigned z, w;
        if (nZ == 1) { z = 0u; w = L; }
        else if (zfast) { z = L % (unsigned)nZ; w = L / (unsigned)nZ; }
        else { z = L / (unsigned)per; w = L - z * (unsigned)per; }
        const unsigned gid = (w * inv) >> 24, r = w - gid * nig;
        u.pm = (int)((gid << gsh) + (r & ((1u << gsh) - 1u))); u.pn = (int)(r >> gsh); u.z = (int)z; return true;
    }
};

template <class Epi, bool DIAG = false>
__device__ __forceinline__ void gemm_phase(LAS unsigned char* lds, const Gemm g, const Order& S, const Epi& E) {
    const int tid = opaque_tid(), wid = __builtin_amdgcn_readfirstlane(tid >> 6), lane = tid & 63, wr = wid >> 2, wc = wid & 3, fr = lane & 15, fq = lane >> 4;
    const int K = g.K, nt = K / BK;
    unsigned voffA[2], voffB[2];
#pragma unroll
    for (int i = 0; i < 2; ++i) { int R, C; stage_rc(tid * 16 + i * 8192, R, C); const int Rb = Epi::PERM ? ((R & ~31) + perm32(R & 31)) : R;
        voffA[i] = (unsigned)(R * g.lda + C) * 2u; voffB[i] = (unsigned)(Rb * g.ldb + C) * 2u; }
    const size_t kstep = (size_t)(BK * 2);
    const size_t hstepA = g.hsA ? (size_t)g.hsA : (size_t)HALF * g.lda * 2, hstepB = g.hsB ? (size_t)g.hsB : (size_t)HALF * g.ldb * 2;
    const size_t tstepA = g.tsA ? (size_t)g.tsA : 2 * hstepA, tstepB = g.tsB ? (size_t)g.tsB : 2 * hstepB;
    const unsigned ldsw = (unsigned)wid * 1024u;
    const int aoff = lds_byte(wr * 64 + fr, fq * 8), boff = lds_byte(wc * 32 + fr, fq * 8);
#define PG8_SA(b, h) (((b) * 2 + (h)) * HTB)
#define PG8_SB(b, h) ((4 + (b) * 2 + (h)) * HTB)
#define PG8_STAGE(bufoff, gbase, voff) do { _Pragma("unroll") for (int _i = 0; _i < 2; ++_i) \
        __builtin_amdgcn_global_load_lds((const unsigned*)((const char*)(gbase) + (voff)[_i]), (LAS unsigned*)(lds + (bufoff) + ldsw + _i * 8192), 16, 0, 0); } while (0)
#define PG8_LDA(dst, b, h) do { _Pragma("unroll") for (int m = 0; m < 4; ++m) _Pragma("unroll") for (int k = 0; k < 2; ++k) dst[m][k] = *(const LAS bf16x8*)(lds + PG8_SA(b, h) + aoff + m * 2048 + k * 1024); } while (0)
#define PG8_LDB(dst, b, h) do { _Pragma("unroll") for (int n = 0; n < 2; ++n) _Pragma("unroll") for (int k = 0; k < 2; ++k) dst[n][k] = *(const LAS bf16x8*)(lds + PG8_SB(b, h) + boff + n * 2048 + k * 1024); } while (0)
#define PG8_MMA(ai, bj, At, Bt) do { __builtin_amdgcn_s_setprio(1); _Pragma("unroll") for (int m = 0; m < 4; ++m) _Pragma("unroll") for (int n = 0; n < 2; ++n) _Pragma("unroll") for (int k = 0; k < 2; ++k) \
        acc[ai][bj][m][n] = __builtin_amdgcn_mfma_f32_16x16x32_bf16(Bt[n][k], At[m][k], acc[ai][bj][m][n], 0, 0, 0); __builtin_amdgcn_s_setprio(0); } while (0)
#define PG8_WAIT_V(n) asm volatile("s_waitcnt vmcnt(" #n ")" ::: "memory")
#define PG8_WAIT_L(n) asm volatile("s_waitcnt lgkmcnt(" #n ")" ::: "memory")
#define PG8_BAR __builtin_amdgcn_s_barrier()
#define PG8_SCHED __builtin_amdgcn_sched_barrier(0)
#define PG8_UA(u) ((const char*)g.A + ((size_t)(u).z * (size_t)g.sA) * 2 + (size_t)(u).pm * tstepA)
#define PG8_UB(u) ((const char*)g.Bt + ((size_t)(u).z * (size_t)g.sB) * 2 + (size_t)(u).pn * tstepB)
    Unit cur, nxt; int ui = 0;
    if (!S.next(0, cur)) return;
    f32x4 acc[2][2][4][2];
#pragma unroll
    for (int a = 0; a < 2; ++a)
#pragma unroll
        for (int b = 0; b < 2; ++b)
#pragma unroll
            for (int m = 0; m < 4; ++m)
#pragma unroll
                for (int n = 0; n < 2; ++n) acc[a][b][m][n] = (f32x4){0.f, 0.f, 0.f, 0.f};
    bf16x8 At[4][2], B0[2][2], B1[2][2];
    const char* cA = PG8_UA(cur); const char* cB = PG8_UB(cur);
    PG8_STAGE(PG8_SB(0, 0), cB, voffB); PG8_STAGE(PG8_SB(0, 1), cB + hstepB, voffB); PG8_STAGE(PG8_SA(0, 0), cA, voffA); PG8_STAGE(PG8_SA(0, 1), cA + hstepA, voffA);
    if (wr == 1) PG8_BAR;
    PG8_WAIT_V(2); PG8_BAR;
    PG8_STAGE(PG8_SB(1, 0), cB + kstep, voffB); PG8_STAGE(PG8_SA(1, 0), cA + kstep, voffA); PG8_STAGE(PG8_SB(1, 1), cB + hstepB + kstep, voffB);
    PG8_WAIT_V(6); PG8_BAR;
    for (;;) {
        const bool has_next = S.next(ui + 1, nxt);
        const char* nA = has_next ? PG8_UA(nxt) : cA; const char* nB = has_next ? PG8_UB(nxt) : cB;
        for (int t = 0; t < nt; t += 2) {
            const bool last = (t == nt - 2);
            const char* a1 = cA + (size_t)(t + 1) * kstep;
            const char* a2 = last ? nA : cA + (size_t)(t + 2) * kstep; const char* b2 = last ? nB : cB + (size_t)(t + 2) * kstep;
            const char* a3 = a2 + kstep; const char* b3 = b2 + kstep;
            PG8_LDB(B0, 0, 0); PG8_LDB(B1, 0, 1); PG8_SCHED; PG8_LDA(At, 0, 0); PG8_STAGE(PG8_SA(1, 1), a1 + hstepA, voffA);
            PG8_WAIT_V(8); PG8_WAIT_L(0); PG8_BAR; PG8_MMA(0, 0, At, B0); if (!DIAG) PG8_MMA(0, 1, At, B1); PG8_BAR; PG8_SCHED;
            PG8_LDA(At, 0, 1); PG8_STAGE(PG8_SB(0, 0), b2, voffB); PG8_STAGE(PG8_SB(0, 1), b2 + hstepB, voffB); PG8_STAGE(PG8_SA(0, 0), a2, voffA);
            PG8_WAIT_V(8); PG8_WAIT_L(0); PG8_BAR; if (!DIAG) PG8_MMA(1, 0, At, B0); PG8_MMA(1, 1, At, B1); PG8_BAR; PG8_SCHED;
            PG8_LDB(B0, 1, 0); PG8_LDB(B1, 1, 1); PG8_SCHED; PG8_LDA(At, 1, 0); PG8_STAGE(PG8_SA(0, 1), a2 + hstepA, voffA);
            PG8_WAIT_V(8); PG8_WAIT_L(0); PG8_BAR; PG8_MMA(0, 0, At, B0); if (!DIAG) PG8_MMA(0, 1, At, B1); PG8_BAR; PG8_SCHED;
            PG8_LDA(At, 1, 1); PG8_STAGE(PG8_SB(1, 0), b3, voffB); PG8_STAGE(PG8_SB(1, 1), b3 + hstepB, voffB); PG8_STAGE(PG8_SA(1, 0), a3, voffA);
            PG8_WAIT_V(8); PG8_WAIT_L(0); PG8_BAR; if (!DIAG) PG8_MMA(1, 0, At, B0); PG8_MMA(1, 1, At, B1); PG8_BAR; PG8_SCHED;
        }
        if (wr == 0) PG8_BAR;
        E(acc, cur, wr, wc, fr, fq);
        if (!has_next) break;
#pragma unroll
        for (int a = 0; a < 2; ++a)
#pragma unroll
            for (int b = 0; b < 2; ++b)
#pragma unroll
                for (int m = 0; m < 4; ++m)
#pragma unroll
                    for (int n = 0; n < 2; ++n) acc[a][b][m][n] = (f32x4){0.f, 0.f, 0.f, 0.f};
        cur = nxt; cA = nA; cB = nB; ++ui;
        if (wr == 1) PG8_BAR;
    }
    PG8_WAIT_V(0);
    PG8_BAR;
#undef PG8_SA
#undef PG8_SB
#undef PG8_STAGE
#undef PG8_LDA
#undef PG8_LDB
#undef PG8_MMA
#undef PG8_WAIT_V
#undef PG8_WAIT_L
#undef PG8_BAR
#undef PG8_SCHED
#undef PG8_UA
#undef PG8_UB
}

typedef const f32x4 (&AccRef)[2][2][4][2];

struct EpiStore {
    static constexpr bool PERM = true;
    bf16_t* O; int ldc; long zoff;
    __device__ __forceinline__ void operator()(AccRef acc, const Unit& u, int wr, int wc, int fr, int fq) const {
        bf16_t* base = O + (size_t)u.z * zoff + (size_t)(u.pm * BM + wr * 64 + fr) * ldc + u.pn * BM + wc * 32 + 8 * fq;
#pragma unroll
        for (int ai = 0; ai < 2; ++ai)
#pragma unroll
            for (int m = 0; m < 4; ++m) { bf16_t* rowp = base + (size_t)(ai * HALF + m * 16) * ldc;
#pragma unroll
                for (int bj = 0; bj < 2; ++bj) { const f32x4 v0 = acc[ai][bj][m][0], v1 = acc[ai][bj][m][1];
                    u32x4 w; w.x = cvt_pk_bf16(v0[0], v0[1]); w.y = cvt_pk_bf16(v0[2], v0[3]); w.z = cvt_pk_bf16(v1[0], v1[1]); w.w = cvt_pk_bf16(v1[2], v1[3]);
                    *(u32x4*)(rowp + bj * HALF) = w; } }
    }
};

struct EpiFT {
    static constexpr bool PERM = true;
    bf16_t* FT; bf16_t* FTc;
    __device__ __forceinline__ void operator()(AccRef acc, const Unit& u, int wr, int wc, int fr, int fq) const {
        const int tl = wc * 32 + 8 * fq;
        bf16_t* base; size_t rstride; int poff;
        if (u.pn < 128) { const int b = u.pn >> 4; const int n = ((u.pn & 15) << 8) + tl; base = FT + (size_t)b * 512 * 8192 + n; rstride = 8192; poff = 4096; }
        else { const int b = u.pn - 128; base = FTc + (size_t)b * 512 * 512 + tl; rstride = 512; poff = 256; }
#pragma unroll
        for (int ai = 0; ai < 2; ++ai)
#pragma unroll
            for (int m = 0; m < 4; ++m) { const int R = u.pm * BM + ai * HALF + wr * 64 + m * 16 + fr; const int part = R >> 9, c = R & 511;
                bf16_t* rowp = base + (size_t)c * rstride + part * poff;
#pragma unroll
                for (int bj = 0; bj < 2; ++bj) { const f32x4 v0 = acc[ai][bj][m][0], v1 = acc[ai][bj][m][1];
                    u32x4 w; w.x = cvt_pk_bf16(v0[0], v0[1]); w.y = cvt_pk_bf16(v0[2], v0[3]); w.z = cvt_pk_bf16(v1[0], v1[1]); w.w = cvt_pk_bf16(v1[2], v1[3]);
                    *(u32x4*)(rowp + bj * HALF) = w; } }
    }
};

struct EpiQKV {
    static constexpr bool PERM = true;
    bf16_t* Q; bf16_t* Kb; const float* rope;
    __device__ __forceinline__ void operator()(AccRef acc, const Unit& u, int wr, int wc, int fr, int fq) const {
        const bool isctx = u.pm >= (NLAT / BM);
#pragma unroll
        for (int ai = 0; ai < 2; ++ai) {
            f32x4 csa[4], csb[4];
#pragma unroll
            for (int m = 0; m < 4; ++m) { const int pos = (u.pm * BM + ai * HALF + wr * 64 + m * 16 + fr) & (SEQ - 1); const int pp = (wc & 1) ? (pos & 63) : (pos >> 6);
                csa[m] = (f32x4){1.f, 0.f, 1.f, 0.f}; csb[m] = csa[m];
                if (!isctx) { const f32x4* tp = (const f32x4*)(rope + (size_t)(pp * 16 + 4 * fq) * 2); csa[m] = tp[0]; csb[m] = tp[1]; } }
            asm volatile("" ::: "memory");
#pragma unroll
            for (int m = 0; m < 4; ++m) {
                const int R = u.pm * BM + ai * HALF + wr * 64 + m * 16 + fr;
                const int pos = R & (SEQ - 1);
                const f32x4 cs0 = csa[m], cs1 = csb[m];
#pragma unroll
                for (int bj = 0; bj < 2; ++bj) {
                    f32x4 v0 = acc[ai][bj][m][0], v1 = acc[ai][bj][m][1];
                    if (u.pn < 2 || bj == 0) {
                        f32x4 o0, o1;
                        o0[0] = v0[0] * cs0[0] - v0[1] * cs0[1]; o0[1] = v0[0] * cs0[1] + v0[1] * cs0[0];
                        o0[2] = v0[2] * cs0[2] - v0[3] * cs0[3]; o0[3] = v0[2] * cs0[3] + v0[3] * cs0[2];
                        o1[0] = v1[0] * cs1[0] - v1[1] * cs1[1]; o1[1] = v1[0] * cs1[1] + v1[1] * cs1[0];
                        o1[2] = v1[2] * cs1[2] - v1[3] * cs1[3]; o1[3] = v1[2] * cs1[3] + v1[3] * cs1[2];
                        if (u.pn < 2) { o0 = o0 * QSCALE; o1 = o1 * QSCALE; }
                        v0 = o0; v1 = o1;
                    }
                    u32x4 w; w.x = cvt_pk_bf16(v0[0], v0[1]); w.y = cvt_pk_bf16(v0[2], v0[3]); w.z = cvt_pk_bf16(v1[0], v1[1]); w.w = cvt_pk_bf16(v1[2], v1[3]);
                    if (u.pn < 2) *(u32x4*)(Q + (size_t)R * 512 + u.pn * BM + bj * HALF + wc * 32 + 8 * fq) = w;
                    else *(u32x4*)(Kb + (size_t)R * 256 + bj * HALF + wc * 32 + 8 * fq) = w;
                }
                asm volatile("" ::: "memory");
            }
        }
    }
};

struct EpiSwiGLU {
    static constexpr bool PERM = true;
    bf16_t* U;
    __device__ __forceinline__ void operator()(AccRef acc, const Unit& u, int wr, int wc, int fr, int fq) const {
        bf16_t* base = U + (size_t)(u.pm * BM + wr * 64 + fr) * FF + u.pn * HALF + wc * 32 + 8 * fq;
#pragma unroll
        for (int ai = 0; ai < 2; ++ai)
#pragma unroll
            for (int m = 0; m < 4; ++m) { bf16_t* rowp = base + (size_t)(ai * HALF + m * 16) * FF;
                f32x4 o0, o1; silu_mul8(acc[ai][0][m][0], acc[ai][1][m][0], acc[ai][0][m][1], acc[ai][1][m][1], o0, o1);
                u32x4 w; w.x = cvt_pk_bf16(o0[0], o0[1]); w.y = cvt_pk_bf16(o0[2], o0[3]); w.z = cvt_pk_bf16(o1[0], o1[1]); w.w = cvt_pk_bf16(o1[2], o1[3]);
                *(u32x4*)(rowp) = w; }
    }
};

template <class TB> struct EpiResH {
    static constexpr bool PERM = true;
    const TB* baseL; const TB* baseC; bf16_t* outL; bf16_t* outC; const float* gate;
    int zcol;
    static __device__ __forceinline__ void ld8(const float* p, f32x4& a, f32x4& b) { a = *(const f32x4*)p; b = *(const f32x4*)(p + 4); }
    static __device__ __forceinline__ void ld8(const bf16_t* p, f32x4& a, f32x4& b) { const u32x4 w = *(const u32x4*)p;
        a = (f32x4){__uint_as_float(w.x << 16), __uint_as_float(w.x & 0xffff0000u), __uint_as_float(w.y << 16), __uint_as_float(w.y & 0xffff0000u)};
        b = (f32x4){__uint_as_float(w.z << 16), __uint_as_float(w.z & 0xffff0000u), __uint_as_float(w.w << 16), __uint_as_float(w.w & 0xffff0000u)}; }
    __device__ __forceinline__ void operator()(AccRef acc, const Unit& u, int wr, int wc, int fr_, int fq_) const {
        int fr = fr_, fq = fq_; asm volatile("" : "+v"(fr), "+v"(fq));
        const int r0 = u.pm * BM; const TB* bs; bf16_t* os; int mb;
        if (r0 < NLAT) { bs = baseL + (size_t)r0 * D; os = outL + (size_t)r0 * D; mb = r0 >> 12; }
        else { bs = baseC + (size_t)(r0 - NLAT) * D; os = outC + (size_t)(r0 - NLAT) * D; mb = 8; }
        const int col0 = u.z * zcol + u.pn * BM + wc * 32 + 8 * fq;
        f32x4 gv[2][2];
#pragma unroll
        for (int bj = 0; bj < 2; ++bj)
#pragma unroll
            for (int n = 0; n < 2; ++n) gv[bj][n] = *(const f32x4*)(gate + (size_t)mb * MODW + col0 + bj * HALF + 4 * n);
#pragma unroll
        for (int ai = 0; ai < 2; ++ai) {
            f32x4 b4[4][2][2];
#pragma unroll
            for (int mm = 0; mm < 4; ++mm) { const unsigned off = (unsigned)((ai * HALF + wr * 64 + mm * 16 + fr) * D + col0);
#pragma unroll
                for (int bj = 0; bj < 2; ++bj) ld8(bs + off + bj * HALF, b4[mm][bj][0], b4[mm][bj][1]); }
            asm volatile("" ::: "memory");
#pragma unroll
            for (int mm = 0; mm < 4; ++mm) { const unsigned off = (unsigned)((ai * HALF + wr * 64 + mm * 16 + fr) * D + col0);
#pragma unroll
                for (int bj = 0; bj < 2; ++bj) { const f32x4 o0 = b4[mm][bj][0] + gv[bj][0] * acc[ai][bj][mm][0], o1 = b4[mm][bj][1] + gv[bj][1] * acc[ai][bj][mm][1];
                    u32x4 w; w.x = cvt_pk_bf16(o0[0], o0[1]); w.y = cvt_pk_bf16(o0[2], o0[3]); w.z = cvt_pk_bf16(o1[0], o1[1]); w.w = cvt_pk_bf16(o1[2], o1[3]);
                    *(u32x4*)(os + off + bj * HALF) = w; } }
            asm volatile("" ::: "memory"); }
    }
};
struct EpiDftSym {
    static constexpr bool PERM = true;
    bf16_t* MIXp; const float* a2048;
    __device__ __forceinline__ void operator()(AccRef acc, const Unit& u, int wr, int wc, int fr_, int fq_) const {
        int fr = fr_, fq = fq_; asm volatile("" : "+v"(fr), "+v"(fq));
        const int c0 = u.pn * HALF + wc * 32 + 8 * fq;
        const f32x4 t0 = *(const f32x4*)(a2048 + u.z * 512 + c0), t1 = *(const f32x4*)(a2048 + u.z * 512 + c0 + 4);
        const float sg2 = (fr & 1) ? -2.0f : 2.0f;
        bf16_t* base = MIXp + (size_t)u.z * SEQ * 1024 + c0;
#pragma unroll
        for (int m = 0; m < 4; ++m) { const int k = u.pm * HALF + wr * 64 + m * 16 + fr;
            const f32x4 u10 = acc[0][0][m][0], u11 = acc[0][0][m][1], u20 = acc[1][1][m][0], u21 = acc[1][1][m][1];
            const f32x4 y0 = u10 + u20, y1 = u11 + u21;
            u32x4 w; w.x = cvt_pk_bf16(y0[0], y0[1]); w.y = cvt_pk_bf16(y0[2], y0[3]); w.z = cvt_pk_bf16(y1[0], y1[1]); w.w = cvt_pk_bf16(y1[2], y1[3]);
            *(u32x4*)(base + (size_t)k * 1024) = w;
            if (k > 0) { const f32x4 z0 = u10 - u20 + t0 * sg2, z1 = u11 - u21 + t1 * sg2;
                u32x4 v; v.x = cvt_pk_bf16(z0[0], z0[1]); v.y = cvt_pk_bf16(z0[2], z0[3]); v.z = cvt_pk_bf16(z1[0], z1[1]); v.w = cvt_pk_bf16(z1[2], z1[3]);
                *(u32x4*)(base + (size_t)(SEQ - k) * 1024) = v; } }
    }
};
struct EpiPartial {
    static constexpr bool PERM = false;
    float* S; long zoff;
    __device__ __forceinline__ void operator()(AccRef acc, const Unit& u, int wr, int wc, int fr, int fq) const {
        float* os = S + (size_t)u.z * zoff + (size_t)(u.pm * BM) * D + u.pn * BM + wc * 32 + 4 * fq;
#pragma unroll
        for (int ai = 0; ai < 2; ++ai)
#pragma unroll
            for (int m = 0; m < 4; ++m) { const size_t off = (size_t)(ai * HALF + wr * 64 + m * 16 + fr) * D;
#pragma unroll
                for (int bj = 0; bj < 2; ++bj)
#pragma unroll
                    for (int n = 0; n < 2; ++n) *(f32x4*)(os + off + bj * HALF + n * 16) = acc[ai][bj][m][n]; }
    }
};
}

namespace att {
constexpr int KSTR = 144, VSTR = 264;
constexpr int KBUF = 128 * KSTR, VBUF = 64 * VSTR, BUF = KBUF + VBUF;
struct Args { const bf16_t* Q; const bf16_t* Kb; bf16_t* MIX; const float* sink; };
__device__ __forceinline__ int crow(int r, int hi) { return (r & 3) + 8 * (r >> 2) + 4 * hi; }

__device__ __forceinline__ void unit(LAS unsigned char* lds, const Args& A, int b, int blk, int kvh) {
    const int tid = opaque_tid(), lane = tid & 63, r32 = lane & 31, hi = lane >> 5, wid = __builtin_amdgcn_readfirstlane(tid >> 6);
    const bool cq = blk >= 32;
    const int hq = kvh * 4 + (wid >> 1);
    const int qloc = (wid & 1) * 64;
    const size_t qrow0 = cq ? (size_t)NLAT + b * CTX + (blk - 32) * 128 : (size_t)b * SEQ + blk * 128;
    bf16x8 qf[2][4];
#pragma unroll
    for (int qt = 0; qt < 2; ++qt)
#pragma unroll
        for (int ks = 0; ks < 4; ++ks) qf[qt][ks] = *(const bf16x8*)(A.Q + (qrow0 + qloc + qt * 32 + r32) * 512 + hq * 64 + ks * 16 + hi * 8);
    f32x16 o[2][2];
#pragma unroll
    for (int a = 0; a < 2; ++a)
#pragma unroll
        for (int c = 0; c < 2; ++c)
#pragma unroll
            for (int r = 0; r < 16; ++r) o[a][c][r] = 0.f;
    const float sk = A.sink[hq] * LOG2E;
    float mrow[2] = {sk, sk}, lrow[2] = {hi == 0 ? 1.f : 0.f, hi == 0 ? 1.f : 0.f};
    const int c_first = cq ? 3 : (blk == 0 ? 1 : 0);
    u32x4 kreg[2], vreg[2];
    auto next_chunk = [&](int c) { int n = c + 1; if (!cq && n == 2 && blk == 31) n = 3; return n; };
    auto gload = [&](int c) {
#pragma unroll
        for (int i = 0; i < 2; ++i) {
            const int p = tid + 512 * i;
            const int key = p >> 3, part = p & 7;
            size_t krow;
            if (c < 3) krow = (size_t)b * SEQ + blk * 128 + (c - 1) * 128 + key; else krow = (size_t)NLAT + b * CTX + (c - 3) * 128 + key;
            kreg[i] = *(const u32x4*)(A.Kb + krow * 256 + kvh * 64 + part * 8);
            vreg[i] = *(const u32x4*)(A.Kb + krow * 256 + 128 + kvh * 64 + part * 8);
        }
    };
    auto lstore = [&](int buf) {
        LAS unsigned char* kb = lds + buf * BUF; LAS unsigned char* vb = kb + KBUF;
#pragma unroll
        for (int i = 0; i < 2; ++i) {
            const int p = tid + 512 * i; const int key = p >> 3, part = p & 7;
            *(LAS u32x4*)(kb + key * KSTR + part * 16) = kreg[i];
            LAS unsigned short* vp = (LAS unsigned short*)(vb + (part * 8) * VSTR + key * 2);
            const unsigned x0 = vreg[i].x, x1 = vreg[i].y, x2 = vreg[i].z, x3 = vreg[i].w;
            vp[0 * (VSTR / 2)] = (unsigned short)(x0 & 0xffff); vp[1 * (VSTR / 2)] = (unsigned short)(x0 >> 16);
            vp[2 * (VSTR / 2)] = (unsigned short)(x1 & 0xffff); vp[3 * (VSTR / 2)] = (unsigned short)(x1 >> 16);
            vp[4 * (VSTR / 2)] = (unsigned short)(x2 & 0xffff); vp[5 * (VSTR / 2)] = (unsigned short)(x2 >> 16);
            vp[6 * (VSTR / 2)] = (unsigned short)(x3 & 0xffff); vp[7 * (VSTR / 2)] = (unsigned short)(x3 >> 16);
        }
    };
    gload(c_first); lstore(0); __syncthreads();
    int buf = 0;
    for (int c = c_first; c < 5;) {
        const int cn = next_chunk(c);
        if (cn < 5) gload(cn);
        LAS unsigned char* kb = lds + buf * BUF; LAS unsigned char* vb = kb + KBUF;
#pragma unroll 1
        for (int kt = 0; kt < 4; ++kt) {
            f32x16 s[2];
#pragma unroll
            for (int r = 0; r < 16; ++r) { s[0][r] = 0.f; s[1][r] = 0.f; }
#pragma unroll
            for (int ks = 0; ks < 4; ++ks) {
                const bf16x8 kf = *(const LAS bf16x8*)(kb + (kt * 32 + r32) * KSTR + (ks * 16 + hi * 8) * 2);
                s[0] = __builtin_amdgcn_mfma_f32_32x32x16_bf16(kf, qf[0][ks], s[0], 0, 0, 0);
                s[1] = __builtin_amdgcn_mfma_f32_32x32x16_bf16(kf, qf[1][ks], s[1], 0, 0, 0);
            }
            if (c == 0 || c == 2) {
#pragma unroll
                for (int qt = 0; qt < 2; ++qt) { const int q = qloc + qt * 32 + r32;
#pragma unroll
                    for (int r = 0; r < 16; ++r) { const int j = kt * 32 + crow(r, hi); const bool ok = (c == 0) ? (j >= q) : (j <= q); if (!ok) s[qt][r] = -INFINITY; } }
            }
            bf16x8 pb[2][2];
#pragma unroll
            for (int qt = 0; qt < 2; ++qt) {
                float mx = s[qt][0];
#pragma unroll
                for (int r = 1; r < 16; ++r) mx = fmaxf(mx, s[qt][r]);
                mx = fmaxf(mx, __shfl_xor(mx, 32));
                const float mnew = fmaxf(mrow[qt], mx);
                const float alpha = __builtin_amdgcn_exp2f(mrow[qt] - mnew);
                mrow[qt] = mnew;
                float ls = 0.f;
#pragma unroll
                for (int r = 0; r < 16; ++r) { const float pv = __builtin_amdgcn_exp2f(s[qt][r] - mnew); s[qt][r] = pv; ls += pv; }
                lrow[qt] = lrow[qt] * alpha + ls;
#pragma unroll
                for (int dt = 0; dt < 2; ++dt)
#pragma unroll
                    for (int r = 0; r < 16; ++r) o[dt][qt][r] *= alpha;
#pragma unroll
                for (int st = 0; st < 2; ++st) {
                    u32x4 w; w.x = cvt_pk_bf16(s[qt][8 * st + 0], s[qt][8 * st + 1]); w.y = cvt_pk_bf16(s[qt][8 * st + 2], s[qt][8 * st + 3]);
                    w.z = cvt_pk_bf16(s[qt][8 * st + 4], s[qt][8 * st + 5]); w.w = cvt_pk_bf16(s[qt][8 * st + 6], s[qt][8 * st + 7]);
                    pb[qt][st] = __builtin_bit_cast(bf16x8, w);
                }
            }
#pragma unroll
            for (int st = 0; st < 2; ++st)
#pragma unroll
                for (int dt = 0; dt < 2; ++dt) {
                    const LAS unsigned char* vp = vb + (dt * 32 + r32) * VSTR + (kt * 32 + st * 16 + hi * 4) * 2;
                    const u32x2 lo = *(const LAS u32x2*)vp, hh = *(const LAS u32x2*)(vp + 16);
                    const bf16x8 vf = __builtin_bit_cast(bf16x8, (u32x4){lo.x, lo.y, hh.x, hh.y});
                    o[dt][0] = __builtin_amdgcn_mfma_f32_32x32x16_bf16(vf, pb[0][st], o[dt][0], 0, 0, 0);
                    o[dt][1] = __builtin_amdgcn_mfma_f32_32x32x16_bf16(vf, pb[1][st], o[dt][1], 0, 0, 0);
                }
        }
        if (cn < 5) lstore(buf ^ 1);
        __syncthreads();
        buf ^= 1; c = cn;
    }
    {
        LAS unsigned char* stg = lds + wid * 9216;
#pragma unroll
        for (int qt = 0; qt < 2; ++qt) {
            const float lt = lrow[qt] + __shfl_xor(lrow[qt], 32);
            const float inv = 1.0f / lt;
            LAS unsigned char* srow = stg + (qt * 32 + r32) * 144 + 8 * hi;
#pragma unroll
            for (int dt = 0; dt < 2; ++dt)
#pragma unroll
                for (int g = 0; g < 4; ++g) {
                    u32x2 w; w.x = cvt_pk_bf16(o[dt][qt][4 * g] * inv, o[dt][qt][4 * g + 1] * inv); w.y = cvt_pk_bf16(o[dt][qt][4 * g + 2] * inv, o[dt][qt][4 * g + 3] * inv);
                    *(LAS u32x2*)(srow + dt * 64 + 16 * g) = w;
                }
        }
        asm volatile("s_waitcnt lgkmcnt(0)" ::: "memory");
        bf16_t* obase = A.MIX + (qrow0 + qloc) * 1024 + 512 + hq * 64;
#pragma unroll
        for (int i = 0; i < 8; ++i) { const int row = i * 8 + (lane >> 3), ch = lane & 7;
            const u32x4 v = *(const LAS u32x4*)(stg + row * 144 + ch * 16);
            *(u32x4*)(obase + (size_t)row * 1024 + ch * 8) = v; }
    }
    __syncthreads();
}
}


#define XB_TMO      128
#define XB_XCNT(j)  (256  + 64 * (j))
#define XB_XSUB(j)  (1280 + 64 * (j))
#define XB_XGEN(j)  (2304 + 64 * (j))
#define XB_TOP      3328
#define XB_TOPGEN   3392
#define XCD_BAR_WORDS 3456
#define XB_SPIN_CAP (1u << 18)
__device__ __forceinline__ unsigned xb_ld(unsigned* p)              { return __hip_atomic_load(p, __ATOMIC_RELAXED, __HIP_MEMORY_SCOPE_AGENT); }
__device__ __forceinline__ unsigned xb_add(unsigned* p, unsigned v) { return __hip_atomic_fetch_add(p, v, __ATOMIC_RELAXED, __HIP_MEMORY_SCOPE_AGENT); }
__device__ __forceinline__ unsigned xb_xcc_id() { return (unsigned)__builtin_amdgcn_s_getreg((3 << 11) | 20) & 0xFu; }
#define XB_SPIN(cond, bar) do { unsigned _sp = 0; while (cond) { __builtin_amdgcn_s_sleep(1); \
    if ((++_sp & 255u) == 0u) { if (xb_ld(&(bar)[XB_TMO])) break; if (_sp > XB_SPIN_CAP) { atomicAdd(&(bar)[XB_TMO], 1u); break; } } } } while (0)
struct XcdBarrier { unsigned* bar; unsigned x; volatile LAS unsigned* st; };
__device__ __forceinline__ XcdBarrier xcd_barrier_post(unsigned* bar, volatile LAS unsigned* st) {
    XcdBarrier b; b.bar = bar; b.x = xb_xcc_id(); b.st = st;
    if (threadIdx.x == 0) (void)xb_add(&bar[XB_XCNT(b.x)], 1u);
    return b;
}
__device__ __forceinline__ void xcd_barrier_complete(unsigned* bar, unsigned x, unsigned& nloc, unsigned& nx) {
    const unsigned G = gridDim.x * gridDim.y * gridDim.z;
    unsigned sum, cnt, mine, sp = 0u;
    for (;;) {
        sum = 0u; cnt = 0u; mine = 0u;
#pragma unroll
        for (unsigned j = 0; j < 16; ++j) { const unsigned c = xb_ld(&bar[XB_XCNT(j)]); sum += c; cnt += (c > 0u) ? 1u : 0u; mine = (j == x) ? c : mine; }
        if (sum == G) break;
        __builtin_amdgcn_s_sleep(1);
        if ((++sp & 255u) == 0u) { if (xb_ld(&bar[XB_TMO])) break; if (sp > XB_SPIN_CAP) { atomicAdd(&bar[XB_TMO], 1u); break; } }
    }
    nloc = mine > 0u ? mine : 1u; nx = cnt > 0u ? cnt : 1u;
}
__device__ __forceinline__ void xcd_barrier(const XcdBarrier& b) {
    asm volatile("s_waitcnt vmcnt(0)" ::: "memory");
    __syncthreads();
    if (threadIdx.x == 0) {
        unsigned* bar = b.bar;
        __builtin_amdgcn_s_waitcnt(0);
        unsigned nloc = b.st[0], nx = b.st[1];
        if (nloc == 0u) { xcd_barrier_complete(bar, b.x, nloc, nx); b.st[0] = nloc; b.st[1] = nx; }
        const unsigned old = xb_add(&bar[XB_XSUB(b.x)], 1u);
        const unsigned gen = old / nloc;
        if (old + 1u == (gen + 1u) * nloc) {
            __builtin_amdgcn_fence(__ATOMIC_RELEASE, "agent");
            asm volatile("s_waitcnt vmcnt(0)" ::: "memory");
            const unsigned og = xb_add(&bar[XB_TOP], 1u);
            const unsigned tg = og / nx;
            if (og + 1u == (tg + 1u) * nx) xb_add(&bar[XB_TOPGEN], 1u);
            else XB_SPIN(xb_ld(&bar[XB_TOPGEN]) == tg, bar);
            __builtin_amdgcn_fence(__ATOMIC_ACQUIRE, "agent");
            xb_add(&bar[XB_XGEN(b.x)], 1u);
            asm volatile("s_waitcnt vmcnt(0)" ::: "memory");
        } else {
            XB_SPIN(xb_ld(&bar[XB_XGEN(b.x)]) == gen, bar);
            __builtin_amdgcn_fence(__ATOMIC_ACQUIRE, "agent");
            asm volatile("s_waitcnt vmcnt(0)" ::: "memory");
        }
    }
    __syncthreads();
}

struct Params {
    const float *x, *c, *ctx, *c_ctx, *ada_w, *ada_b, *norm_mix_g, *norm_ffn_g, *mix_in_w, *mix_out_w, *attn_sink, *pool_w, *pool_scale, *ffn_w1, *ffn_w3, *ffn_w2, *final_g;
    float* out; unsigned char* ws;
};

__device__ __forceinline__ void tr_item(const float* W, int spitch, int ncols, bf16_t* WT, int dpitch, int mode, int roff, const float* nscale, LAS float* scr, int item, int lane) {
    const int nblk = ncols / 32, kb = item / nblk, nb = item % nblk, k0 = 64 * kb, n0 = 32 * nb;
    float tv[32];
#pragma unroll
    for (int i = 0; i < 32; ++i) tv[i] = W[(size_t)(k0 + 2 * i + (lane >> 5)) * spitch + n0 + (lane & 31)];
#pragma unroll
    for (int i = 0; i < 32; ++i) scr[(2 * i + (lane >> 5)) * 33 + (lane & 31)] = tv[i];
    asm volatile("s_waitcnt lgkmcnt(0)" ::: "memory");
    const int c = lane & 7;
#pragma unroll
    for (int j = 0; j < 4; ++j) { const int n = (lane >> 3) + 8 * j; const LAS float* s = scr + (8 * c) * 33 + n;
        const float sc = nscale ? nscale[n0 + n] : 1.0f;
        const int gn = n0 + n; const int drow = (mode == 0) ? (roff + gn) : ((gn >> 7) * 256 + (gn & 127) + roff);
        u32x4 o; o.x = cvt_pk_bf16(s[0 * 33] * sc, s[1 * 33] * sc); o.y = cvt_pk_bf16(s[2 * 33] * sc, s[3 * 33] * sc); o.z = cvt_pk_bf16(s[4 * 33] * sc, s[5 * 33] * sc); o.w = cvt_pk_bf16(s[6 * 33] * sc, s[7 * 33] * sc);
        *(u32x4*)(WT + (size_t)drow * dpitch + k0 + 8 * c) = o; }
    asm volatile("s_waitcnt lgkmcnt(0)" ::: "memory");
}

template <class TS>
__device__ __forceinline__ void norm_pass(const TS* srcL, const TS* srcC, const float* gvec, const float* modl, int shift_off, int scale_off, bf16_t* XN, int M, int gw, int NGW) {
    const int lane = opaque_tid() & 63;
    for (int row0 = gw * 4; row0 < M; row0 += NGW * 4) {
        const TS* src; int mb;
        if (row0 < NLAT) { src = srcL + (size_t)row0 * D; mb = row0 >> 12; } else { src = srcC + (size_t)(row0 - NLAT) * D; mb = 8; }
        f32x4 v[4][4];
#pragma unroll
        for (int r = 0; r < 4; ++r)
#pragma unroll
            for (int j = 0; j < 4; ++j) v[r][j] = ld4(src + (size_t)r * D + lane * 4 + 256 * j);
        float rstd[4];
#pragma unroll
        for (int r = 0; r < 4; ++r) { float ss = 0.f;
#pragma unroll
            for (int j = 0; j < 4; ++j) ss += (v[r][j].x * v[r][j].x + v[r][j].y * v[r][j].y) + (v[r][j].z * v[r][j].z + v[r][j].w * v[r][j].w);
            rstd[r] = rsqrtf(wave_sum(ss) * (1.0f / D) + EPS); }
        const float* mrow = modl + (size_t)mb * MODW;
#pragma unroll
        for (int j = 0; j < 4; ++j) { const int c = lane * 4 + 256 * j;
            const f32x4 g4 = *(const f32x4*)(gvec + c), sc4 = *(const f32x4*)(mrow + scale_off + c), sh4 = *(const f32x4*)(mrow + shift_off + c);
            const f32x4 G4 = g4 * (sc4 + 1.0f);
#pragma unroll
            for (int r = 0; r < 4; ++r) { const f32x4 q = v[r][j] * rstd[r] * G4 + sh4;
                u32x2 w; w.x = cvt_pk_bf16(q.x, q.y); w.y = cvt_pk_bf16(q.z, q.w);
                ((u32x2*)(XN + (size_t)(row0 + r) * D) + lane)[64 * j] = w; } }
    }
}

template <int HALF>
__device__ __forceinline__ void pool_rows(const f32x2 (&v)[47], f32x2 G2, int t0, int N, bf16_t* po) {
    f32x2 S = (f32x2){0.f, 0.f};
#pragma unroll
    for (int i = 8 - HALF; i < 8 + HALF; ++i) S += v[i];
#pragma unroll
    for (int t = 0; t < 32; ++t) {
        const int tt = t0 + t;
        const int lo = (tt - HALF) > 0 ? (tt - HALF) : 0, hh = (tt + HALF) < N ? (tt + HALF) : N;
        const float icnt = 1.0f / (float)(hh - lo);
        const f32x2 r = G2 * (S * icnt - v[t + 8]);
        *(unsigned*)(po + (size_t)t * D) = cvt_pk_bf16(r.x, r.y);
        if (t < 31) S += v[t + 8 + HALF] - v[t + 8 - HALF];
    }
}
struct PoolItem { int t0, N, mb; const bf16_t* base; size_t orow0; };
__device__ __forceinline__ PoolItem pool_item(int item, const bf16_t* srcL, const bf16_t* srcC) {
    PoolItem q;
    if (item < 1024) { const int seq = item >> 7; q.t0 = (item & 127) * 32; q.N = SEQ; q.base = srcL + (size_t)seq * SEQ * D; q.mb = seq; q.orow0 = (size_t)seq * SEQ; }
    else { const int it = item - 1024; const int seq = it >> 3; q.t0 = (it & 7) * 32; q.N = CTX; q.base = srcC + (size_t)seq * CTX * D; q.mb = 8; q.orow0 = (size_t)NLAT + seq * CTX; }
    return q;
}
__device__ __forceinline__ void pool_load(f32x2 (&v)[47], const PoolItem& q, int c0) {
    const bf16_t* colp = q.base + c0;
#pragma unroll
    for (int i = 0; i < 47; ++i) { const int t = q.t0 - 8 + i; v[i] = (t >= 0 && t < q.N) ? ld2(colp + (size_t)t * D) : (f32x2){0.f, 0.f}; }
}
__device__ __forceinline__ void pool_pass(const bf16_t* srcL, const bf16_t* srcC, const float* gvec, const float* modl, int scale_off, bf16_t* PO, bool with_ctx, LAS float* lds_f, int G) {
    const int tid = opaque_tid(), lane = tid & 63, wave = tid >> 6;
    LAS float* part = lds_f;
    LAS float* srs = lds_f + 8 * 48;
    const int nitems = 1024 + (with_ctx ? 64 : 0);
    int q = 0; while ((q + 1) * G <= nitems) ++q;
    const int rem = nitems - q * G, bxi = (int)blockIdx.x;
    const int i0 = bxi * q + (bxi < rem ? bxi : rem), i1 = i0 + q + (bxi < rem ? 1 : 0);
    const int c0 = 2 * tid;
    const int grp = c0 >> 8;
    const f32x2 g2 = *(const f32x2*)(gvec + c0);
    if (i0 >= i1) return;
    f32x2 v[47], vn[47];
    PoolItem cur = pool_item(i0, srcL, srcC);
    pool_load(v, cur, c0);
    for (int item = i0; item < i1; ++item) {
        PoolItem nxt = cur;
        const bool has_next = item + 1 < i1;
        if (has_next) { nxt = pool_item(item + 1, srcL, srcC); pool_load(vn, nxt, c0); }
#pragma unroll
        for (int i = 0; i < 47; ++i) { const float s = wave_sum(v[i].x * v[i].x + v[i].y * v[i].y); if (lane == 0) part[wave * 48 + i] = s; }
        __syncthreads();
        if (tid < 47) { float s = 0.f;
#pragma unroll
            for (int w = 0; w < 8; ++w) s += part[w * 48 + tid];
            srs[tid] = rsqrtf(s * (1.0f / D) + EPS); }
        __syncthreads();
#pragma unroll
        for (int i = 0; i < 47; ++i) v[i] = v[i] * srs[i];
        const f32x2 sc2 = *(const f32x2*)(modl + (size_t)cur.mb * MODW + scale_off + c0);
        const f32x2 G2 = g2 * (sc2 + 1.0f);
        bf16_t* po = PO + (cur.orow0 + cur.t0) * D + c0;
        if (grp == 0) pool_rows<1>(v, G2, cur.t0, cur.N, po);
        else if (grp == 1) pool_rows<2>(v, G2, cur.t0, cur.N, po);
        else if (grp == 2) pool_rows<4>(v, G2, cur.t0, cur.N, po);
        else pool_rows<8>(v, G2, cur.t0, cur.N, po);
        __syncthreads();
        if (has_next) {
#pragma unroll
            for (int i = 0; i < 47; ++i) v[i] = vn[i];
            cur = nxt; }
    }
}

__device__ __forceinline__ float bf2f(unsigned short h) { return __uint_as_float((unsigned)h << 16); }
__device__ __forceinline__ void fold_pass(const bf16_t* FT, bf16_t* FTF, float* A2048, bf16_t* MIXp, int gw, int NGW) {
    const int lane = opaque_tid() & 63;
    for (int r = gw; r < 4096; r += NGW) {
        const bf16_t* a = FT + (size_t)r * 8192; bf16_t* o = FTF + (size_t)r * 4096;
        bf16x8 lo[2][4], mi[2][4]; unsigned short m0[2][4];
        const unsigned short a2048 = a[2048];
#pragma unroll
        for (int part = 0; part < 2; ++part)
#pragma unroll
            for (int j = 0; j < 4; ++j) { const bf16_t* s = a + part * 4096; const int n0 = 8 * (lane + 64 * j);
                lo[part][j] = *(const bf16x8*)(s + n0);
                mi[part][j] = *(const bf16x8*)(s + 4096 - n0 - 8);
                m0[part][j] = s[(n0 > 0) ? (4096 - n0) : 0]; }
        asm volatile("" ::: "memory");
        float alt = 0.f;
#pragma unroll
        for (int part = 0; part < 2; ++part) { const float sg = part ? -1.0f : 1.0f;
#pragma unroll
            for (int j = 0; j < 4; ++j) { const int n0 = 8 * (lane + 64 * j);
                float v[8];
                v[0] = bf2f((unsigned short)lo[part][j][0]) + sg * bf2f(m0[part][j]);
#pragma unroll
                for (int e = 1; e < 8; ++e) v[e] = bf2f((unsigned short)lo[part][j][e]) + sg * bf2f((unsigned short)mi[part][j][8 - e]);
                if (n0 == 0) v[0] = part ? bf2f(a2048) : bf2f((unsigned short)lo[part][j][0]);
                if (part == 0) alt += ((v[0] - v[1]) + (v[2] - v[3])) + ((v[4] - v[5]) + (v[6] - v[7]));
                u32x4 w; w.x = cvt_pk_bf16(v[0], v[1]); w.y = cvt_pk_bf16(v[2], v[3]); w.z = cvt_pk_bf16(v[4], v[5]); w.w = cvt_pk_bf16(v[6], v[7]);
                *(u32x4*)(o + part * 2048 + n0) = w; } }
        alt = wave_sum(alt);
        if (lane == 0) { const float a2 = bf2f(a2048) * (1.0f / 64.0f); A2048[r] = a2;
            MIXp[((size_t)(r >> 9) * SEQ + 2048) * 1024 + (r & 511)] = (bf16_t)(cvt_pk_bf16(alt * (1.0f / 64.0f) + a2, 0.f) & 0xffffu); }
    }
}

__device__ __forceinline__ void ffn_weights_convert(const Params& p, bf16_t* W13, bf16_t* W2, int l_lo, int l_hi, int widx, int nw, LAS float* scr) {
    const int lane = opaque_tid() & 63;
    constexpr int I_W = 16 * 88, I_2 = 44 * 32, I_L = 2 * I_W + I_2;
    const int n = (l_hi - l_lo) * I_L;
    for (int it = widx; it < n; it += nw) {
        const int l = l_lo + it / I_L; const int r = it % I_L;
        if (r < I_W) tr_item(p.ffn_w1 + (size_t)l * D * FF, FF, FF, W13 + (size_t)l * W13_L, D, 1, 0, nullptr, scr, r, lane);
        else if (r < 2 * I_W) tr_item(p.ffn_w3 + (size_t)l * D * FF, FF, FF, W13 + (size_t)l * W13_L, D, 1, 128, nullptr, scr, r - I_W, lane);
        else tr_item(p.ffn_w2 + (size_t)l * FF * D, D, D, W2 + (size_t)l * W2_L, FF, 0, 0, nullptr, scr, r - 2 * I_W, lane);
    }
}

__global__ void __launch_bounds__(512, 2) fwd_kernel(Params p) {
    extern __shared__ __attribute__((aligned(16))) unsigned char lds_raw[];
    LAS unsigned char* lds = (LAS unsigned char*)lds_raw;
    cg::grid_group grid = cg::this_grid();
    const int tid = threadIdx.x, lane = tid & 63, wave = __builtin_amdgcn_readfirstlane(tid >> 6);
    const int G = gridDim.x, bx = blockIdx.x;
    const int vcu = (G % 8 == 0) ? (bx % 8) * (G / 8) + bx / 8 : bx;
    const int gw = vcu * 8 + wave, NGW = G * 8;
    const int gtid = bx * 512 + tid, NT = G * 512;
    unsigned char* ws = p.ws;
    volatile LAS unsigned* bst = (volatile LAS unsigned*)(lds + 131072 + 1024);
    if (tid < 2) bst[tid] = 0u;
    __syncthreads();
    XcdBarrier xbar = xcd_barrier_post((unsigned*)(ws + WS_BAR), bst);
    float* MOD = (float*)(ws + WS_MOD); float* ROPE = (float*)(ws + WS_ROPE); bf16_t* DFT256 = (bf16_t*)(ws + WS_DFT256); bf16_t* HC = (bf16_t*)(ws + WS_HC); bf16_t* HB = (bf16_t*)(ws + WS_HB);
    bf16_t* DFT = (bf16_t*)(ws + WS_DFT); bf16_t* XN = (bf16_t*)(ws + WS_XN);
    bf16_t* W13 = (bf16_t*)(ws + WS_W13); bf16_t* W2 = (bf16_t*)(ws + WS_W2); bf16_t* WQKV = (bf16_t*)(ws + WS_WQKV); bf16_t* WF = (bf16_t*)(ws + WS_WF); bf16_t* WO = (bf16_t*)(ws + WS_WO); bf16_t* WP = (bf16_t*)(ws + WS_WP);
    bf16_t* U = (bf16_t*)(ws + WS_U); bf16_t* Qb = (bf16_t*)(ws + WS_Q); bf16_t* Kb = (bf16_t*)(ws + WS_K);
    float* A2048 = (float*)(ws + WS_DFT256 + 512 * 1024);
    bf16_t* FTF = (bf16_t*)(ws + WS_FTF); bf16_t* FT = (bf16_t*)(ws + WS_FT); bf16_t* FTc = (bf16_t*)(ws + WS_FTC); bf16_t* MIX = (bf16_t*)(ws + WS_MIX);

    {
        LAS float* sS = (LAS float*)lds;
        LAS float* sR = (LAS float*)(lds + 9 * 1024 * 4);
        for (int idx = tid; idx < 9 * 1024; idx += 512) { const int r = idx >> 10, k = idx & 1023; const float v = r < 8 ? p.c[r * 1024 + k] : p.c_ctx[k]; sS[idx] = v / (1.0f + __expf(-v)); }
        __syncthreads();
        for (int item = bx; item < 4 * 96; item += G) {
            const int layer = item / 96, j0 = (item % 96) * 64;
            const float* W = p.ada_w + (size_t)layer * D * MODW + j0 + lane;
            float a0 = 0.f, a1 = 0.f, a2 = 0.f, a3 = 0.f, a4 = 0.f, a5 = 0.f, a6 = 0.f, a7 = 0.f, a8 = 0.f;
#pragma unroll 1
            for (int kb = 0; kb < 128; kb += 32) {
                float wv[32];
#pragma unroll
                for (int e = 0; e < 32; ++e) wv[e] = W[(size_t)(wave * 128 + kb + e) * MODW];
#pragma unroll
                for (int e = 0; e < 32; ++e) { const int k = wave * 128 + kb + e;
                    a0 += sS[k] * wv[e]; a1 += sS[1024 + k] * wv[e]; a2 += sS[2048 + k] * wv[e]; a3 += sS[3072 + k] * wv[e]; a4 += sS[4096 + k] * wv[e];
                    a5 += sS[5120 + k] * wv[e]; a6 += sS[6144 + k] * wv[e]; a7 += sS[7168 + k] * wv[e]; a8 += sS[8192 + k] * wv[e]; } }
            LAS float* rr = sR + wave * 9 * 64 + lane;
            rr[0] = a0; rr[64] = a1; rr[128] = a2; rr[192] = a3; rr[256] = a4; rr[320] = a5; rr[384] = a6; rr[448] = a7; rr[512] = a8;
            __syncthreads();
            for (int o = tid; o < 576; o += 512) { const int r = o >> 6, l = o & 63; float s = 0.f;
#pragma unroll
                for (int w = 0; w < 8; ++w) s += sR[(w * 9 + r) * 64 + l];
                MOD[((size_t)layer * 9 + r) * MODW + j0 + l] = s + p.ada_b[(size_t)layer * MODW + j0 + l]; }
            __syncthreads();
        }
        {
            LAS float* wt = (LAS float*)lds;
            LAS float* tc = (LAS float*)(lds + 32 * 129 * 4);
            for (int item = bx; item < 256; item += G) {
                const int j = item >> 7, h = (item >> 5) & 3, k0 = (item & 31) * 32;
                __syncthreads();
                if (tid < 128) { const float t = (float)tid * (1.0f / 128.0f); tc[tid] = __builtin_amdgcn_cosf(t); tc[128 + tid] = __builtin_amdgcn_sinf(t); }
                for (int idx = tid; idx < 32 * 128; idx += 512) { const int kk = idx >> 7, i = idx & 127; wt[kk * 129 + i] = p.mix_in_w[((size_t)j * D + k0 + kk) * 1280 + h * 128 + i]; }
                __syncthreads();
                const int jj = tid & 127, kq = tid >> 7;
                float ac[8], as[8];
#pragma unroll
                for (int e = 0; e < 8; ++e) { ac[e] = 0.f; as[e] = 0.f; }
                for (int i = 0; i < 128; ++i) { const int ph = (i * jj) & 127; const float cv = tc[ph], sv = tc[128 + ph];
#pragma unroll
                    for (int e = 0; e < 8; ++e) { const float w = wt[(kq * 8 + e) * 129 + i]; ac[e] += w * cv; as[e] += w * sv; } }
                const float nrm = 0.08838834764831845f;
                u32x4 oc, os;
                oc.x = cvt_pk_bf16(ac[0] * nrm, ac[1] * nrm); oc.y = cvt_pk_bf16(ac[2] * nrm, ac[3] * nrm); oc.z = cvt_pk_bf16(ac[4] * nrm, ac[5] * nrm); oc.w = cvt_pk_bf16(ac[6] * nrm, ac[7] * nrm);
                os.x = cvt_pk_bf16(as[0] * nrm, as[1] * nrm); os.y = cvt_pk_bf16(as[2] * nrm, as[3] * nrm); os.z = cvt_pk_bf16(as[4] * nrm, as[5] * nrm); os.w = cvt_pk_bf16(as[6] * nrm, as[7] * nrm);
                bf16_t* dst = WF + (size_t)j * WF_L + (size_t)(h * 128 + jj) * D + k0 + kq * 8;
                *(u32x4*)dst = oc; *(u32x4*)(dst + (size_t)512 * D) = os;
            }
            __syncthreads();
        }
        {
            LAS float* scr = (LAS float*)(lds + wave * 8448);
            constexpr int I_QKV = 16 * 24, I_O = 16 * 32, I_E = I_QKV + I_O, I_P = 4 * 32;
            constexpr int NITEMS = 2 * I_E + 2 * I_P;
            ffn_weights_convert(p, W13, W2, 0, 1, gw, NGW, scr);
            for (int it = gw; it < NITEMS; it += NGW) {
                int r = it;
                if (r < 2 * I_E) { const int j = r / I_E; r -= j * I_E;
                    if (r < I_QKV) tr_item(p.mix_in_w + (size_t)j * D * 1280 + 512, 1280, 768, WQKV + (size_t)j * WQKV_L, D, 0, 0, nullptr, scr, r, lane);
                    else tr_item(p.mix_out_w + (size_t)j * D * D, D, D, WO + (size_t)j * WO_L, D, 0, 0, nullptr, scr, r - I_QKV, lane);
                    continue; }
                r -= 2 * I_E;
                { const int j = r / I_P; r -= j * I_P; const int gq = r / 32; r -= gq * 32;
                  tr_item(p.pool_w + ((size_t)j * 4 + gq) * 65536, 256, 256, WP + (size_t)j * WP_L + (size_t)gq * 65536, 256, 0, 0, p.pool_scale + (size_t)j * D + gq * 256, scr, r, lane); }
            }
        }
        for (int idx = gtid; idx < 4096 * 512; idx += NT) {
            const int k = idx >> 9, n0 = (idx & 511) * 8;
            float v[8];
#pragma unroll
            for (int e = 0; e < 8; ++e) { const int np = n0 + e; float r;
                if (np < 2048) r = __builtin_amdgcn_cosf((float)((k * np) & 4095) * (1.0f / 4096.0f));
                else if (np == 2048) r = (k & 1) ? -1.0f : 1.0f;
                else r = -__builtin_amdgcn_sinf((float)((k * (np - 2048)) & 4095) * (1.0f / 4096.0f));
                v[e] = r * (1.0f / 64.0f); }
            u32x4 o; o.x = cvt_pk_bf16(v[0], v[1]); o.y = cvt_pk_bf16(v[2], v[3]); o.z = cvt_pk_bf16(v[4], v[5]); o.w = cvt_pk_bf16(v[6], v[7]);
            *(u32x4*)(DFT + (size_t)k * 4096 + n0) = o;
        }
        for (int idx = gtid; idx < 256 * 64; idx += NT) {
            const int k = idx >> 6, n0 = (idx & 63) * 8; const bool sp = n0 >= 256; const int nn = n0 & 255;
            float v[8];
#pragma unroll
            for (int e = 0; e < 8; ++e) { const float t = (float)((k * (nn + e)) & 255) * (1.0f / 256.0f); v[e] = (sp ? -__builtin_amdgcn_sinf(t) : __builtin_amdgcn_cosf(t)) * (1.0f / 16.0f); }
            u32x4 o; o.x = cvt_pk_bf16(v[0], v[1]); o.y = cvt_pk_bf16(v[2], v[3]); o.z = cvt_pk_bf16(v[4], v[5]); o.w = cvt_pk_bf16(v[6], v[7]);
            *(u32x4*)(DFT256 + (size_t)k * 512 + n0) = o;
        }
        for (int idx = gtid; idx < 64 * 16; idx += NT) {
            const int pos = idx >> 4, f = idx & 15;
            const float inv = exp2f(-(float)f * (13.287712379549449f / 16.0f));
            const float turns = (float)pos * inv * 0.15915494309189535f;
            const float fr = turns - floorf(turns);
            ROPE[2 * idx] = __builtin_amdgcn_cosf(fr); ROPE[2 * idx + 1] = __builtin_amdgcn_sinf(fr);
        }
    }
    grid.sync();

    for (int layer = 0; layer < DEPTH; ++layer) {
        const float* modl = MOD + (size_t)layer * 9 * MODW;
        const int jj = layer >> 1;
        const bool upd_ctx = layer < 2;
        if ((layer & 1) == 0) {
            const int Mrows = MALL;
            if (layer == 0) norm_pass(p.x, p.ctx, p.norm_mix_g + (size_t)layer * D, modl, 0, D, XN, Mrows, gw, NGW);
            else norm_pass(HB, HC, p.norm_mix_g + (size_t)layer * D, modl, 0, D, XN, Mrows, gw, NGW);
            xcd_barrier(xbar);
            { pg8::Gemm g{XN, WQKV + (size_t)jj * WQKV_L, D, D, D, 0, 0}; pg8::Order S(Mrows / 256, 3, 1, G, vcu, 3);
              pg8::EpiQKV E{Qb, Kb, ROPE}; pg8::gemm_phase(lds, g, S, E); }
            { const int ntok = upd_ctx ? MALL : NLAT;
              pg8::Gemm g{WF + (size_t)jj * WF_L, XN, D, D, D, 0, 0}; pg8::Order S(4, ntok / 256, 1, G, G - 1 - vcu, 2);
              pg8::EpiFT E{FT, FTc}; pg8::gemm_phase(lds, g, S, E); }
            xcd_barrier(xbar);
            if (upd_ctx && G > 32) { if (vcu >= 32) fold_pass(FT, FTF, A2048, MIX, (vcu - 32) * 8 + wave, (G - 32) * 8); }
            else fold_pass(FT, FTF, A2048, MIX, gw, NGW);
            { att::Args A{Qb, Kb, MIX, p.attn_sink + jj * 8};
              const int nun = 512 + (upd_ctx ? 32 : 0);
              for (int un = vcu; un < nun; un += G) {
                  int b, blk, kvh;
                  if (un < 512) { b = un >> 6; blk = (un >> 1) & 31; kvh = un & 1; } else { const int q = un - 512; b = q >> 2; blk = 32 + ((q >> 1) & 1); kvh = q & 1; }
                  att::unit(lds, A, b, blk, kvh);
              } }
            xcd_barrier(xbar);
            { pg8::Gemm g{DFT, FTF, 2048, 4096, 4096, 0, (long)512 * 4096, 4096, 4096, (long)128 * 4096 * 2, (long)128 * 4096 * 2};
              pg8::Order S(16, 4, 8, G, vcu, 3);
              pg8::EpiDftSym E{MIX, A2048}; pg8::gemm_phase<pg8::EpiDftSym, true>(lds, g, S, E); }
            if (upd_ctx) { pg8::Gemm g{DFT256, FTc, 512, 512, 512, 0, (long)512 * 512}; pg8::Order S(1, 2, 8, G, vcu, 0);
              pg8::EpiStore E{MIX + (size_t)NLAT * 1024, 1024, (long)CTX * 1024}; pg8::gemm_phase(lds, g, S, E); }
            xcd_barrier(xbar);
            { const int Mo = upd_ctx ? MALL : NLAT;
              pg8::Gemm g{MIX, WO + (size_t)jj * WO_L, D, D, D, 0, 0}; pg8::Order S(Mo / 256, 4, 1, G, vcu, 3);
              if (layer == 0) { pg8::EpiResH<float> E{p.x, p.ctx, HB, HC, modl + 2 * D, 0}; pg8::gemm_phase(lds, g, S, E); }
              else { pg8::EpiResH<bf16_t> E{HB, HC, HB, HC, modl + 2 * D, 0}; pg8::gemm_phase(lds, g, S, E); } }
            xcd_barrier(xbar);
        } else {
            pool_pass(HB, HC, p.norm_mix_g + (size_t)layer * D, modl, D, MIX, upd_ctx, (LAS float*)lds, G);
            xcd_barrier(xbar);
            { const int Mo = upd_ctx ? MALL : NLAT;
              pg8::Gemm g{MIX, WP + (size_t)jj * WP_L, 256, D, 256, 256, 65536}; pg8::Order S(Mo / 256, 1, 4, G, vcu, 3, 1);
              pg8::EpiResH<bf16_t> E{HB, HC, HB, HC, modl + 2 * D, 256}; pg8::gemm_phase(lds, g, S, E); }
            xcd_barrier(xbar);
        }
        const int Mf = upd_ctx ? MALL : NLAT;
        norm_pass(HB, HC, p.norm_ffn_g + (size_t)layer * D, modl, 3 * D, 4 * D, XN, Mf, gw, NGW);
        xcd_barrier(xbar);
        { pg8::Gemm g{XN, W13 + (size_t)layer * W13_L, D, D, D, 0, 0}; pg8::Order S(Mf / 256, 22, 1, G, vcu, 3);
          pg8::EpiSwiGLU E{U}; pg8::gemm_phase(lds, g, S, E); }
        xcd_barrier(xbar);
        { pg8::Gemm g{U, W2 + (size_t)layer * W2_L, FF, FF, FF, 0, 0}; pg8::Order S(NLAT / 256, 4, 1, G, vcu, 3);
          pg8::EpiResH<bf16_t> E{HB, HC, HB, HC, modl + 5 * D, 0}; pg8::gemm_phase(lds, g, S, E); }
        if (upd_ctx) {
            float* SL = (float*)(ws + WS_SLAB);
            { pg8::Gemm g{U + (size_t)NLAT * FF, W2 + (size_t)layer * W2_L, FF / 2, FF, FF, FF / 2, FF / 2}; pg8::Order S(NCTX / 256, 4, 2, G, vcu, 3);
              pg8::EpiPartial E{SL, (long)NCTX * D}; pg8::gemm_phase(lds, g, S, E); }
            { const int cb = (G > 64) ? 64 : 0;
              if (vcu >= cb) ffn_weights_convert(p, W13, W2, layer == 0 ? 1 : 2, layer == 0 ? 2 : 4, (vcu - cb) * 8 + wave, (G - cb) * 8, (LAS float*)(lds + wave * 8448)); }
            xcd_barrier(xbar);
            { const int lane_c = opaque_tid() & 63; const float* g2 = modl + (size_t)8 * MODW + 5 * D;
              for (int row = gw; row < NCTX; row += NGW) {
                  bf16_t* hr = HC + (size_t)row * D + lane_c * 4; const f32x4* s0 = (const f32x4*)(SL + (size_t)row * D) + lane_c; const f32x4* s1 = s0 + (size_t)NCTX * D / 4;
                  f32x4 hv[4], sa[4], sb[4];
#pragma unroll
                  for (int j = 0; j < 4; ++j) { hv[j] = ld4(hr + 256 * j); sa[j] = s0[64 * j]; sb[j] = s1[64 * j]; }
                  asm volatile("" ::: "memory");
#pragma unroll
                  for (int j = 0; j < 4; ++j) { const f32x4 o = hv[j] + *(const f32x4*)(g2 + lane_c * 4 + 256 * j) * (sa[j] + sb[j]);
                      u32x2 w; w.x = cvt_pk_bf16(o.x, o.y); w.y = cvt_pk_bf16(o.z, o.w); *(u32x2*)(hr + 256 * j) = w; } } }
        }
        xcd_barrier(xbar);
    }
    { const int lane_f = opaque_tid() & 63;
      f32x4 g4[4];
#pragma unroll
      for (int j = 0; j < 4; ++j) g4[j] = *(const f32x4*)(p.final_g + lane_f * 4 + 256 * j);
      for (int row0 = gw * 4; row0 < NLAT; row0 += NGW * 4) {
        f32x4* xr = (f32x4*)(p.out + (size_t)row0 * D) + lane_f;
        f32x4 v[4][4];
#pragma unroll
        for (int r = 0; r < 4; ++r)
#pragma unroll
            for (int j = 0; j < 4; ++j) v[r][j] = ld4(HB + (size_t)(row0 + r) * D + lane_f * 4 + 256 * j);
#pragma unroll
        for (int r = 0; r < 4; ++r) { float ss = 0.f;
#pragma unroll
            for (int j = 0; j < 4; ++j) ss += (v[r][j].x * v[r][j].x + v[r][j].y * v[r][j].y) + (v[r][j].z * v[r][j].z + v[r][j].w * v[r][j].w);
            const float rstd = rsqrtf(wave_sum(ss) * (1.0f / D) + EPS);
#pragma unroll
            for (int j = 0; j < 4; ++j) xr[r * (D / 4) + 64 * j] = v[r][j] * rstd * g4[j]; }
      } }
}

extern "C" void kernel_launch(void* const* d_in, const int* in_sizes, int n_in, void* d_out, int out_size, void* d_ws, size_t ws_size, hipStream_t stream) {
    static int grid_blocks = 0;
    if (grid_blocks == 0) {
        if (n_in != 17 || ws_size < WS_END) { fprintf(stderr, "kernel_launch: unexpected inputs (n_in %d, ws %zu)\n", n_in, ws_size); grid_blocks = -1; return; }
        int dev = 0, cus = 0, per_cu = 0;
        hipGetDevice(&dev);
        hipDeviceGetAttribute(&cus, hipDeviceAttributeMultiprocessorCount, dev);
        hipFuncSetAttribute((const void*)fwd_kernel, hipFuncAttributeMaxDynamicSharedMemorySize, LDS_BYTES);
        hipOccupancyMaxActiveBlocksPerMultiprocessor(&per_cu, (const void*)fwd_kernel, 512, LDS_BYTES);
        if (per_cu < 1) { fprintf(stderr, "kernel_launch: occupancy query gave %d\n", per_cu); per_cu = 1; }
        (void)hipGetLastError();
        grid_blocks = cus;
    }
    if (grid_blocks < 0) return;
    (void)hipMemsetAsync((unsigned char*)d_ws + WS_BAR, 0, BAR_BYTES, stream);
    Params p{};
    const float** pf = (const float**)&p;
    for (int i = 0; i < 17; ++i) pf[i] = (const float*)d_in[i];
    p.out = (float*)d_out; p.ws = (unsigned char*)d_ws;
    void* args[] = {&p};
    hipError_t e = hipLaunchCooperativeKernel((const void*)fwd_kernel, dim3(grid_blocks), dim3(512), args, LDS_BYTES, stream);
    if (e != hipSuccess) fprintf(stderr, "cooperative launch failed: %s (grid %d)\n", hipGetErrorString(e), grid_blocks);
}
```

```cpp
#include <hip/hip_runtime.h>
#include <hip/hip_cooperative_groups.h>
#include <cstdio>
#include <cstdint>
namespace cg = cooperative_groups;

#define LAS __attribute__((address_space(3)))
typedef unsigned short bf16_t;
typedef short bf16x8 __attribute__((ext_vector_type(8)));
typedef short s16x4 __attribute__((ext_vector_type(4)));
typedef float f32x4 __attribute__((ext_vector_type(4)));
typedef float f32x2 __attribute__((ext_vector_type(2)));
typedef float f32x16 __attribute__((ext_vector_type(16)));
typedef unsigned u32x4 __attribute__((ext_vector_type(4)));
typedef unsigned u32x2 __attribute__((ext_vector_type(2)));

constexpr int D = 1024, NB = 8, SEQ = 4096, NLAT = NB * SEQ, CTX = 256, NCTX = NB * CTX, MALL = NLAT + NCTX, FF = 2816, DEPTH = 4;
constexpr int MODW = 6 * D;
constexpr float EPS = 1e-6f;
constexpr float QSCALE = 0.125f * 1.4426950408889634f;
constexpr float LOG2E = 1.4426950408889634f;

constexpr size_t MiB = 1u << 20;
constexpr size_t WS_MOD = 0, WS_ROPE = 1 * MiB, WS_DFT256 = 2 * MiB, WS_HC = 3 * MiB, WS_HB = 11 * MiB, WS_XN = 75 * MiB;
constexpr size_t WS_W13 = 143 * MiB, WS_W2 = 187 * MiB, WS_WQKV = 209 * MiB, WS_WF = 212 * MiB, WS_WO = 216 * MiB, WS_WP = 220 * MiB;
constexpr size_t WS_U = 221 * MiB;
constexpr size_t WS_Q = 221 * MiB, WS_K = 255 * MiB, WS_VT = 264 * MiB, WS_VTC = 272 * MiB, WS_FT = 273 * MiB, WS_FTC = 337 * MiB, WS_MIX = 341 * MiB;
constexpr size_t WS_FTF = 410 * MiB;
constexpr size_t WS_SLAB = 442 * MiB;
constexpr size_t WS_DFT = 458 * MiB;
constexpr size_t WS_END = 490 * MiB;
constexpr size_t WS_BAR = 1 * MiB + 512 * 1024, BAR_BYTES = 16384;
constexpr size_t W13_L = (size_t)2 * FF * D, W2_L = (size_t)D * FF, WQKV_L = (size_t)768 * D, WF_L = (size_t)1024 * D, WO_L = (size_t)D * D, WP_L = (size_t)4 * 256 * 256;

constexpr int LDS_BYTES = 147456;

__device__ __forceinline__ unsigned cvt_pk_bf16(float lo, float hi) { unsigned r; asm volatile("v_cvt_pk_bf16_f32 %0, %1, %2" : "=v"(r) : "v"(lo), "v"(hi)); return r; }
__device__ __forceinline__ float wave_sum(float v) {
#pragma unroll
    for (int o = 1; o < 64; o <<= 1) v += __shfl_xor(v, o);
    return v;
}
__device__ __forceinline__ int opaque_tid() { int t = threadIdx.x; asm volatile("" : "+v"(t)); return t; }
__device__ __forceinline__ f32x4 ld4(const float* p) { return *(const f32x4*)p; }
__device__ __forceinline__ f32x4 ld4(const bf16_t* p) { const u32x2 w = *(const u32x2*)p; return (f32x4){__uint_as_float(w.x << 16), __uint_as_float(w.x & 0xffff0000u), __uint_as_float(w.y << 16), __uint_as_float(w.y & 0xffff0000u)}; }
__device__ __forceinline__ f32x2 ld2(const float* p) { return *(const f32x2*)p; }
__device__ __forceinline__ f32x2 ld2(const bf16_t* p) { const unsigned w = *(const unsigned*)p; return (f32x2){__uint_as_float(w << 16), __uint_as_float(w & 0xffff0000u)}; }
__device__ __forceinline__ float silu_f(float x) { return x * __builtin_amdgcn_rcpf(1.0f + __expf(-x)); }
__device__ __forceinline__ void silu_mul8(f32x4 a0, f32x4 b0, f32x4 a1, f32x4 b1, f32x4& o0, f32x4& o1) {
    const f32x4 t0 = a0 * (-1.4426950408889634f), t1 = a1 * (-1.4426950408889634f);
    f32x4 e0, e1;
#pragma unroll
    for (int j = 0; j < 4; ++j) { e0[j] = __builtin_amdgcn_exp2f(t0[j]); e1[j] = __builtin_amdgcn_exp2f(t1[j]); }
    const f32x4 d0 = e0 + 1.0f, d1 = e1 + 1.0f;
    f32x4 r0, r1;
#pragma unroll
    for (int j = 0; j < 4; ++j) { r0[j] = __builtin_amdgcn_rcpf(d0[j]); r1[j] = __builtin_amdgcn_rcpf(d1[j]); }
    o0 = (a0 * b0) * r0; o1 = (a1 * b1) * r1;
}

namespace pg8 {
constexpr int BM = 256, BK = 64, HALF = 128, HTB = HALF * BK * 2, STAGE_BYTES = 8 * HTB, WGM = 8;
__device__ __forceinline__ int lds_byte(int r, int c) { const int st = (r >> 4) * 2 + (c >> 5), rr = r & 15, cc = c & 31, ob = rr * 64 + cc * 2; return st * 1024 + (ob ^ (((ob >> 9) & 1) << 5)); }
__device__ __forceinline__ void stage_rc(int b, int& R, int& C) { const int st = b / 1024, sb = b % 1024, swz = sb ^ (((sb >> 9) & 1) << 5); R = (st >> 1) * 16 + swz / 64; C = (st & 1) * 32 + (swz % 64) / 2; }
__device__ __forceinline__ int perm32(int rho) { const int n = rho >> 4, i = rho & 15; return 8 * (i >> 2) + 4 * n + (i & 3); }

struct Unit { int pm, pn, z; };
struct Gemm { const bf16_t* A; const bf16_t* Bt; int K, lda, ldb; long sA, sB; long hsA = 0, hsB = 0, tsA = 0, tsB = 0; };

struct Order {
    int nN, nZ, per, G, vcu, gsh, zfast; unsigned nig, inv;
    __device__ __forceinline__ Order(int nM_, int nN_, int nZ_, int G_, int vcu_, int gsh_, int zfast_ = 0) {
        nN = nN_; nZ = nZ_; per = nM_ * nN_; G = G_; vcu = vcu_; gsh = gsh_; zfast = zfast_; nig = (unsigned)nN_ << gsh_;
        inv = (unsigned)__builtin_amdgcn_readfirstlane((int)((1u << 24) / nig + 1u));
    }
    __device__ __forceinline__ bool next(int i, Unit& u) const {
        const unsigned L = (unsigned)i * (unsigned)G + (unsigned)vcu;
        if (L >= (unsigned)per * (unsigned)nZ) return false;
        unsigned z, w;
        if (nZ == 1) { z = 0u; w = L; }
        else if (zfast) { z = L % (unsigned)nZ; w = L / (unsigned)nZ; }
        else { z = L / (unsigned)per; w = L - z * (unsigned)per; }
        const unsigned gid = (w * inv) >> 24, r = w - gid * nig;
        u.pm = (int)((gid << gsh) + (r & ((1u << gsh) - 1u))); u.pn = (int)(r >> gsh); u.z = (int)z; return true;
    }
};

template <class Epi, bool DIAG = false>
__device__ __forceinline__ void gemm_phase(LAS unsigned char* lds, const Gemm g, const Order& S, const Epi& E) {
    const int tid = opaque_tid(), wid = __builtin_amdgcn_readfirstlane(tid >> 6), lane = tid & 63, wr = wid >> 2, wc = wid & 3, fr = lane & 15, fq = lane >> 4;
    const int K = g.K, nt = K / BK;
    unsigned voffA[2], voffB[2];
#pragma unroll
    for (int i = 0; i < 2; ++i) { int R, C; stage_rc(tid * 16 + i * 8192, R, C); const int Rb = Epi::PERM ? ((R & ~31) + perm32(R & 31)) : R;
        voffA[i] = (unsigned)(R * g.lda + C) * 2u; voffB[i] = (unsigned)(Rb * g.ldb + C) * 2u; }
    const size_t kstep = (size_t)(BK * 2);
    const size_t hstepA = g.hsA ? (size_t)g.hsA : (size_t)HALF * g.lda * 2, hstepB = g.hsB ? (size_t)g.hsB : (size_t)HALF * g.ldb * 2;
    const size_t tstepA = g.tsA ? (size_t)g.tsA : 2 * hstepA, tstepB = g.tsB ? (size_t)g.tsB : 2 * hstepB;
    const unsigned ldsw = (unsigned)wid * 1024u;
    const int aoff = lds_byte(wr * 64 + fr, fq * 8), boff = lds_byte(wc * 32 + fr, fq * 8);
#define PG8_SA(b, h) (((b) * 2 + (h)) * HTB)
#define PG8_SB(b, h) ((4 + (b) * 2 + (h)) * HTB)
#define PG8_STAGE(bufoff, gbase, voff) do { _Pragma("unroll") for (int _i = 0; _i < 2; ++_i) \
        __builtin_amdgcn_global_load_lds((const unsigned*)((const char*)(gbase) + (voff)[_i]), (LAS unsigned*)(lds + (bufoff) + ldsw + _i * 8192), 16, 0, 0); } while (0)
#define PG8_LDA(dst, b, h) do { _Pragma("unroll") for (int m = 0; m < 4; ++m) _Pragma("unroll") for (int k = 0; k < 2; ++k) dst[m][k] = *(const LAS bf16x8*)(lds + PG8_SA(b, h) + aoff + m * 2048 + k * 1024); } while (0)
#define PG8_LDB(dst, b, h) do { _Pragma("unroll") for (int n = 0; n < 2; ++n) _Pragma("unroll") for (int k = 0; k < 2; ++k) dst[n][k] = *(const LAS bf16x8*)(lds + PG8_SB(b, h) + boff + n * 2048 + k * 1024); } while (0)
#define PG8_MMA(ai, bj, At, Bt) do { __builtin_amdgcn_s_setprio(1); _Pragma("unroll") for (int m = 0; m < 4; ++m) _Pragma("unroll") for (int n = 0; n < 2; ++n) _Pragma("unroll") for (int k = 0; k < 2; ++k) \
        acc[ai][bj][m][n] = __builtin_amdgcn_mfma_f32_16x16x32_bf16(Bt[n][k], At[m][k], acc[ai][bj][m][n], 0, 0, 0); __builtin_amdgcn_s_setprio(0); } while (0)
#define PG8_WAIT_V(n) asm volatile("s_waitcnt vmcnt(" #n ")" ::: "memory")
#define PG8_WAIT_L(n) asm volatile("s_waitcnt lgkmcnt(" #n ")" ::: "memory")
#define PG8_BAR __builtin_amdgcn_s_barrier()
#define PG8_SCHED __builtin_amdgcn_sched_barrier(0)
#define PG8_UA(u) ((const char*)g.A + ((size_t)(u).z * (size_t)g.sA) * 2 + (size_t)(u).pm * tstepA)
#define PG8_UB(u) ((const char*)g.Bt + ((size_t)(u).z * (size_t)g.sB) * 2 + (size_t)(u).pn * tstepB)
    Unit cur, nxt; int ui = 0;
    if (!S.next(0, cur)) return;
    f32x4 acc[2][2][4][2];
#pragma unroll
    for (int a = 0; a < 2; ++a)
#pragma unroll
        for (int b = 0; b < 2; ++b)
#pragma unroll
            for (int m = 0; m < 4; ++m)
#pragma unroll
                for (int n = 0; n < 2; ++n) acc[a][b][m][n] = (f32x4){0.f, 0.f, 0.f, 0.f};
    bf16x8 At[4][2], B0[2][2], B1[2][2];
    const char* cA = PG8_UA(cur); const char* cB = PG8_UB(cur);
    PG8_STAGE(PG8_SB(0, 0), cB, voffB); PG8_STAGE(PG8_SB(0, 1), cB + hstepB, voffB); PG8_STAGE(PG8_SA(0, 0), cA, voffA); PG8_STAGE(PG8_SA(0, 1), cA + hstepA, voffA);
    if (wr == 1) PG8_BAR;
    PG8_WAIT_V(2); PG8_BAR;
    PG8_STAGE(PG8_SB(1, 0), cB + kstep, voffB); PG8_STAGE(PG8_SA(1, 0), cA + kstep, voffA); PG8_STAGE(PG8_SB(1, 1), cB + hstepB + kstep, voffB);
    PG8_WAIT_V(6); PG8_BAR;
    for (;;) {
        const bool has_next = S.next(ui + 1, nxt);
        const char* nA = has_next ? PG8_UA(nxt) : cA; const char* nB = has_next ? PG8_UB(nxt) : cB;
        for (int t = 0; t < nt; t += 2) {
            const bool last = (t == nt - 2);
            const char* a1 = cA + (size_t)(t + 1) * kstep;
            const char* a2 = last ? nA : cA + (size_t)(t + 2) * kstep; const char* b2 = last ? nB : cB + (size_t)(t + 2) * kstep;
            const char* a3 = a2 + kstep; const char* b3 = b2 + kstep;
            PG8_LDB(B0, 0, 0); PG8_LDB(B1, 0, 1); PG8_SCHED; PG8_LDA(At, 0, 0); PG8_STAGE(PG8_SA(1, 1), a1 + hstepA, voffA);
            PG8_WAIT_V(8); PG8_WAIT_L(0); PG8_BAR; PG8_MMA(0, 0, At, B0); if (!DIAG) PG8_MMA(0, 1, At, B1); PG8_BAR; PG8_SCHED;
            PG8_LDA(At, 0, 1); PG8_STAGE(PG8_SB(0, 0), b2, voffB); PG8_STAGE(PG8_SB(0, 1), b2 + hstepB, voffB); PG8_STAGE(PG8_SA(0, 0), a2, voffA);
            PG8_WAIT_V(8); PG8_WAIT_L(0); PG8_BAR; if (!DIAG) PG8_MMA(1, 0, At, B0); PG8_MMA(1, 1, At, B1); PG8_BAR; PG8_SCHED;
            PG8_LDB(B0, 1, 0); PG8_LDB(B1, 1, 1); PG8_SCHED; PG8_LDA(At, 1, 0); PG8_STAGE(PG8_SA(0, 1), a2 + hstepA, voffA);
            PG8_WAIT_V(8); PG8_WAIT_L(0); PG8_BAR; PG8_MMA(0, 0, At, B0); if (!DIAG) PG8_MMA(0, 1, At, B1); PG8_BAR; PG8_SCHED;
            PG8_LDA(At, 1, 1); PG8_STAGE(PG8_SB(1, 0), b3, voffB); PG8_STAGE(PG8_SB(1, 1), b3 + hstepB, voffB); PG8_STAGE(PG8_SA(1, 0), a3, voffA);
            PG8_WAIT_V(8); PG8_WAIT_L(0); PG8_BAR; if (!DIAG) PG8_MMA(1, 0, At, B0); PG8_MMA(1, 1, At, B1); PG8_BAR; PG8_SCHED;
        }
        if (wr == 0) PG8_BAR;
        E(acc, cur, wr, wc, fr, fq);
        if (!has_next) break;
#pragma unroll
        for (int a = 0; a < 2; ++a)
#pragma unroll
            for (int b = 0; b < 2; ++b)
#pragma unroll
                for (int m = 0; m < 4; ++m)
#pragma unroll
                    for (int n = 0; n < 2; ++n) acc[a][b][m][n] = (f32x4){0.f, 0.f, 0.f, 0.f};
        cur = nxt; cA = nA; cB = nB; ++ui;
        if (wr == 1) PG8_BAR;
    }
    PG8_WAIT_V(0);
    PG8_BAR;
#undef PG8_SA
#undef PG8_SB
#undef PG8_STAGE
#undef PG8_LDA
#undef PG8_LDB
#undef PG8_MMA
#undef PG8_WAIT_V
#undef PG8_WAIT_L
#undef PG8_BAR
#undef PG8_SCHED
#undef PG8_UA
#undef PG8_UB
}

typedef const f32x4 (&AccRef)[2][2][4][2];

struct EpiStore {
    static constexpr bool PERM = true;
    bf16_t* O; int ldc; long zoff;
    __device__ __forceinline__ void operator()(AccRef acc, const Unit& u, int wr, int wc, int fr, int fq) const {
        bf16_t* base = O + (size_t)u.z * zoff + (size_t)(u.pm * BM + wr * 64 + fr) * ldc + u.pn * BM + wc * 32 + 8 * fq;
#pragma unroll
        for (int ai = 0; ai < 2; ++ai)
#pragma unroll
            for (int m = 0; m < 4; ++m) { bf16_t* rowp = base + (size_t)(ai * HALF + m * 16) * ldc;
#pragma unroll
                for (int bj = 0; bj < 2; ++bj) { const f32x4 v0 = acc[ai][bj][m][0], v1 = acc[ai][bj][m][1];
                    u32x4 w; w.x = cvt_pk_bf16(v0[0], v0[1]); w.y = cvt_pk_bf16(v0[2], v0[3]); w.z = cvt_pk_bf16(v1[0], v1[1]); w.w = cvt_pk_bf16(v1[2], v1[3]);
                    *(u32x4*)(rowp + bj * HALF) = w; } }
    }
};

struct EpiFT {
    static constexpr bool PERM = true;
    bf16_t* FT; bf16_t* FTc;
    __device__ __forceinline__ void operator()(AccRef acc, const Unit& u, int wr, int wc, int fr, int fq) const {
        const int tl = wc * 32 + 8 * fq;
        bf16_t* base; size_t rstride; int poff;
        if (u.pn < 128) { const int b = u.pn >> 4; const int n = ((u.pn & 15) << 8) + tl; base = FT + (size_t)b * 512 * 8192 + n; rstride = 8192; poff = 4096; }
        else { const int b = u.pn - 128; base = FTc + (size_t)b * 512 * 512 + tl; rstride = 512; poff = 256; }
#pragma unroll
        for (int ai = 0; ai < 2; ++ai)
#pragma unroll
            for (int m = 0; m < 4; ++m) { const int R = u.pm * BM + ai * HALF + wr * 64 + m * 16 + fr; const int part = R >> 9, c = R & 511;
                bf16_t* rowp = base + (size_t)c * rstride + part * poff;
#pragma unroll
                for (int bj = 0; bj < 2; ++bj) { const f32x4 v0 = acc[ai][bj][m][0], v1 = acc[ai][bj][m][1];
                    u32x4 w; w.x = cvt_pk_bf16(v0[0], v0[1]); w.y = cvt_pk_bf16(v0[2], v0[3]); w.z = cvt_pk_bf16(v1[0], v1[1]); w.w = cvt_pk_bf16(v1[2], v1[3]);
                    *(u32x4*)(rowp + bj * HALF) = w; } }
    }
};

struct EpiQKV {
    static constexpr bool PERM = true;
    bf16_t* Q; bf16_t* Kb; const float* rope;
    __device__ __forceinline__ void operator()(AccRef acc, const Unit& u, int wr, int wc, int fr, int fq) const {
        const bool isctx = u.pm >= (NLAT / BM);
#pragma unroll
        for (int ai = 0; ai < 2; ++ai) {
            f32x4 csa[4], csb[4];
#pragma unroll
            for (int m = 0; m < 4; ++m) { const int pos = (u.pm * BM + ai * HALF + wr * 64 + m * 16 + fr) & (SEQ - 1); const int pp = (wc & 1) ? (pos & 63) : (pos >> 6);
                csa[m] = (f32x4){1.f, 0.f, 1.f, 0.f}; csb[m] = csa[m];
                if (!isctx) { const f32x4* tp = (const f32x4*)(rope + (size_t)(pp * 16 + 4 * fq) * 2); csa[m] = tp[0]; csb[m] = tp[1]; } }
            asm volatile("" ::: "memory");
#pragma unroll
            for (int m = 0; m < 4; ++m) {
                const int R = u.pm * BM + ai * HALF + wr * 64 + m * 16 + fr;
                const int pos = R & (SEQ - 1);
                const f32x4 cs0 = csa[m], cs1 = csb[m];
#pragma unroll
                for (int bj = 0; bj < 2; ++bj) {
                    f32x4 v0 = acc[ai][bj][m][0], v1 = acc[ai][bj][m][1];
                    if (u.pn < 2 || bj == 0) {
                        f32x4 o0, o1;
                        o0[0] = v0[0] * cs0[0] - v0[1] * cs0[1]; o0[1] = v0[0] * cs0[1] + v0[1] * cs0[0];
                        o0[2] = v0[2] * cs0[2] - v0[3] * cs0[3]; o0[3] = v0[2] * cs0[3] + v0[3] * cs0[2];
                        o1[0] = v1[0] * cs1[0] - v1[1] * cs1[1]; o1[1] = v1[0] * cs1[1] + v1[1] * cs1[0];
                        o1[2] = v1[2] * cs1[2] - v1[3] * cs1[3]; o1[3] = v1[2] * cs1[3] + v1[3] * cs1[2];
                        if (u.pn < 2) { o0 = o0 * QSCALE; o1 = o1 * QSCALE; }
                        v0 = o0; v1 = o1;
                    }
                    u32x4 w; w.x = cvt_pk_bf16(v0[0], v0[1]); w.y = cvt_pk_bf16(v0[2], v0[3]); w.z = cvt_pk_bf16(v1[0], v1[1]); w.w = cvt_pk_bf16(v1[2], v1[3]);
                    if (u.pn < 2) *(u32x4*)(Q + (size_t)R * 512 + u.pn * BM + bj * HALF + wc * 32 + 8 * fq) = w;
                    else *(u32x4*)(Kb + (size_t)R * 256 + bj * HALF + wc * 32 + 8 * fq) = w;
                }
                asm volatile("" ::: "memory");
            }
        }
    }
};

struct EpiSwiGLU {
    static constexpr bool PERM = true;
    bf16_t* U;
    __device__ __forceinline__ void operator()(AccRef acc, const Unit& u, int wr, int wc, int fr, int fq) const {
        bf16_t* base = U + (size_t)(u.pm * BM + wr * 64 + fr) * FF + u.pn * HALF + wc * 32 + 8 * fq;
#pragma unroll
        for (int ai = 0; ai < 2; ++ai)
#pragma unroll
            for (int m = 0; m < 4; ++m) { bf16_t* rowp = base + (size_t)(ai * HALF + m * 16) * FF;
                f32x4 o0, o1; silu_mul8(acc[ai][0][m][0], acc[ai][1][m][0], acc[ai][0][m][1], acc[ai][1][m][1], o0, o1);
                u32x4 w; w.x = cvt_pk_bf16(o0[0], o0[1]); w.y = cvt_pk_bf16(o0[2], o0[3]); w.z = cvt_pk_bf16(o1[0], o1[1]); w.w = cvt_pk_bf16(o1[2], o1[3]);
                *(u32x4*)(rowp) = w; }
    }
};

template <class TB> struct EpiResH {
    static constexpr bool PERM = true;
    const TB* baseL; const TB* baseC; bf16_t* outL; bf16_t* outC; const float* gate;
    int zcol;
    static __device__ __forceinline__ void ld8(const float* p, f32x4& a, f32x4& b) { a = *(const f32x4*)p; b = *(const f32x4*)(p + 4); }
    static __device__ __forceinline__ void ld8(const bf16_t* p, f32x4& a, f32x4& b) { const u32x4 w = *(const u32x4*)p;
        a = (f32x4){__uint_as_float(w.x << 16), __uint_as_float(w.x & 0xffff0000u), __uint_as_float(w.y << 16), __uint_as_float(w.y & 0xffff0000u)};
        b = (f32x4){__uint_as_float(w.z << 16), __uint_as_float(w.z & 0xffff0000u), __uint_as_float(w.w << 16), __uint_as_float(w.w & 0xffff0000u)}; }
    __device__ __forceinline__ void operator()(AccRef acc, const Unit& u, int wr, int wc, int fr_, int fq_) const {
        int fr = fr_, fq = fq_; asm volatile("" : "+v"(fr), "+v"(fq));
        const int r0 = u.pm * BM; const TB* bs; bf16_t* os; int mb;
        if (r0 < NLAT) { bs = baseL + (size_t)r0 * D; os = outL + (size_t)r0 * D; mb = r0 >> 12; }
        else { bs = baseC + (size_t)(r0 - NLAT) * D; os = outC + (size_t)(r0 - NLAT) * D; mb = 8; }
        const int col0 = u.z * zcol + u.pn * BM + wc * 32 + 8 * fq;
        f32x4 gv[2][2];
#pragma unroll
        for (int bj = 0; bj < 2; ++bj)
#pragma unroll
            for (int n = 0; n < 2; ++n) gv[bj][n] = *(const f32x4*)(gate + (size_t)mb * MODW + col0 + bj * HALF + 4 * n);
#pragma unroll
        for (int ai = 0; ai < 2; ++ai) {
            f32x4 b4[4][2][2];
#pragma unroll
            for (int mm = 0; mm < 4; ++mm) { const unsigned off = (unsigned)((ai * HALF + wr * 64 + mm * 16 + fr) * D + col0);
#pragma unroll
                for (int bj = 0; bj < 2; ++bj) ld8(bs + off + bj * HALF, b4[mm][bj][0], b4[mm][bj][1]); }
            asm volatile("" ::: "memory");
#pragma unroll
            for (int mm = 0; mm < 4; ++mm) { const unsigned off = (unsigned)((ai * HALF + wr * 64 + mm * 16 + fr) * D + col0);
#pragma unroll
                for (int bj = 0; bj < 2; ++bj) { const f32x4 o0 = b4[mm][bj][0] + gv[bj][0] * acc[ai][bj][mm][0], o1 = b4[mm][bj][1] + gv[bj][1] * acc[ai][bj][mm][1];
                    u32x4 w; w.x = cvt_pk_bf16(o0[0], o0[1]); w.y = cvt_pk_bf16(o0[2], o0[3]); w.z = cvt_pk_bf16(o1[0], o1[1]); w.w = cvt_pk_bf16(o1[2], o1[3]);
                    *(u32x4*)(os + off + bj * HALF) = w; } }
            asm volatile("" ::: "memory"); }
    }
};
struct EpiDftSym {
    static constexpr bool PERM = true;
    bf16_t* MIXp; const float* a2048;
    __device__ __forceinline__ void operator()(AccRef acc, const Unit& u, int wr, int wc, int fr_, int fq_) const {
        int fr = fr_, fq = fq_; asm volatile("" : "+v"(fr), "+v"(fq));
        const int c0 = u.pn * HALF + wc * 32 + 8 * fq;
        const f32x4 t0 = *(const f32x4*)(a2048 + u.z * 512 + c0), t1 = *(const f32x4*)(a2048 + u.z * 512 + c0 + 4);
        const float sg2 = (fr & 1) ? -2.0f : 2.0f;
        bf16_t* base = MIXp + (size_t)u.z * SEQ * 1024 + c0;
#pragma unroll
        for (int m = 0; m < 4; ++m) { const int k = u.pm * HALF + wr * 64 + m * 16 + fr;
            const f32x4 u10 = acc[0][0][m][0], u11 = acc[0][0][m][1], u20 = acc[1][1][m][0], u21 = acc[1][1][m][1];
            const f32x4 y0 = u10 + u20, y1 = u11 + u21;
            u32x4 w; w.x = cvt_pk_bf16(y0[0], y0[1]); w.y = cvt_pk_bf16(y0[2], y0[3]); w.z = cvt_pk_bf16(y1[0], y1[1]); w.w = cvt_pk_bf16(y1[2], y1[3]);
            *(u32x4*)(base + (size_t)k * 1024) = w;
            if (k > 0) { const f32x4 z0 = u10 - u20 + t0 * sg2, z1 = u11 - u21 + t1 * sg2;
                u32x4 v; v.x = cvt_pk_bf16(z0[0], z0[1]); v.y = cvt_pk_bf16(z0[2], z0[3]); v.z = cvt_pk_bf16(z1[0], z1[1]); v.w = cvt_pk_bf16(z1[2], z1[3]);
                *(u32x4*)(base + (size_t)(SEQ - k) * 1024) = v; } }
    }
};
struct EpiPartial {
    static constexpr bool PERM = false;
    float* S; long zoff;
    __device__ __forceinline__ void operator()(AccRef acc, const Unit& u, int wr, int wc, int fr, int fq) const {
        float* os = S + (size_t)u.z * zoff + (size_t)(u.pm * BM) * D + u.pn * BM + wc * 32 + 4 * fq;
#pragma unroll
        for (int ai = 0; ai < 2; ++ai)
#pragma unroll
            for (int m = 0; m < 4; ++m) { const size_t off = (size_t)(ai * HALF + wr * 64 + m * 16 + fr) * D;
#pragma unroll
                for (int bj = 0; bj < 2; ++bj)
#pragma unroll
                    for (int n = 0; n < 2; ++n) *(f32x4*)(os + off + bj * HALF + n * 16) = acc[ai][bj][m][n]; }
    }
};
}

namespace att {
constexpr int KSTR = 144, VSTR = 264;
constexpr int KBUF = 128 * KSTR, VBUF = 64 * VSTR, BUF = KBUF + VBUF;
struct Args { const bf16_t* Q; const bf16_t* Kb; bf16_t* MIX; const float* sink; };
__device__ __forceinline__ int crow(int r, int hi) { return (r & 3) + 8 * (r >> 2) + 4 * hi; }

__device__ __forceinline__ void unit(LAS unsigned char* lds, const Args& A, int b, int blk, int kvh) {
    const int tid = opaque_tid(), lane = tid & 63, r32 = lane & 31, hi = lane >> 5, wid = __builtin_amdgcn_readfirstlane(tid >> 6);
    const bool cq = blk >= 32;
    const int hq = kvh * 4 + (wid >> 1);
    const int qloc = (wid & 1) * 64;
    const size_t qrow0 = cq ? (size_t)NLAT + b * CTX + (blk - 32) * 128 : (size_t)b * SEQ + blk * 128;
    bf16x8 qf[2][4];
#pragma unroll
    for (int qt = 0; qt < 2; ++qt)
#pragma unroll
        for (int ks = 0; ks < 4; ++ks) qf[qt][ks] = *(const bf16x8*)(A.Q + (qrow0 + qloc + qt * 32 + r32) * 512 + hq * 64 + ks * 16 + hi * 8);
    f32x16 o[2][2];
#pragma unroll
    for (int a = 0; a < 2; ++a)
#pragma unroll
        for (int c = 0; c < 2; ++c)
#pragma unroll
            for (int r = 0; r < 16; ++r) o[a][c][r] = 0.f;
    const float sk = A.sink[hq] * LOG2E;
    float mrow[2] = {sk, sk}, lrow[2] = {hi == 0 ? 1.f : 0.f, hi == 0 ? 1.f : 0.f};
    const int c_first = cq ? 3 : (blk == 0 ? 1 : 0);
    u32x4 kreg[2], vreg[2];
    auto next_chunk = [&](int c) { int n = c + 1; if (!cq && n == 2 && blk == 31) n = 3; return n; };
    auto gload = [&](int c) {
#pragma unroll
        for (int i = 0; i < 2; ++i) {
            const int p = tid + 512 * i;
            const int key = p >> 3, part = p & 7;
            size_t krow;
            if (c < 3) krow = (size_t)b * SEQ + blk * 128 + (c - 1) * 128 + key; else krow = (size_t)NLAT + b * CTX + (c - 3) * 128 + key;
            kreg[i] = *(const u32x4*)(A.Kb + krow * 256 + kvh * 64 + part * 8);
            vreg[i] = *(const u32x4*)(A.Kb + krow * 256 + 128 + kvh * 64 + part * 8);
        }
    };
    auto lstore = [&](int buf) {
        LAS unsigned char* kb = lds + buf * BUF; LAS unsigned char* vb = kb + KBUF;
#pragma unroll
        for (int i = 0; i < 2; ++i) {
            const int p = tid + 512 * i; const int key = p >> 3, part = p & 7;
            *(LAS u32x4*)(kb + key * KSTR + part * 16) = kreg[i];
            LAS unsigned short* vp = (LAS unsigned short*)(vb + (part * 8) * VSTR + key * 2);
            const unsigned x0 = vreg[i].x, x1 = vreg[i].y, x2 = vreg[i].z, x3 = vreg[i].w;
            vp[0 * (VSTR / 2)] = (unsigned short)(x0 & 0xffff); vp[1 * (VSTR / 2)] = (unsigned short)(x0 >> 16);
            vp[2 * (VSTR / 2)] = (unsigned short)(x1 & 0xffff); vp[3 * (VSTR / 2)] = (unsigned short)(x1 >> 16);
            vp[4 * (VSTR / 2)] = (unsigned short)(x2 & 0xffff); vp[5 * (VSTR / 2)] = (unsigned short)(x2 >> 16);
            vp[6 * (VSTR / 2)] = (unsigned short)(x3 & 0xffff); vp[7 * (VSTR / 2)] = (unsigned short)(x3 >> 16);
        }
    };
    gload(c_first); lstore(0); __syncthreads();
    int buf = 0;
    for (int c = c_first; c < 5;) {
        const int cn = next_chunk(c);
        if (cn < 5) gload(cn);
        LAS unsigned char* kb = lds + buf * BUF; LAS unsigned char* vb = kb + KBUF;
#pragma unroll 1
        for (int kt = 0; kt < 4; ++kt) {
            f32x16 s[2];
#pragma unroll
            for (int r = 0; r < 16; ++r) { s[0][r] = 0.f; s[1][r] = 0.f; }
#pragma unroll
            for (int ks = 0; ks < 4; ++ks) {
                const bf16x8 kf = *(const LAS bf16x8*)(kb + (kt * 32 + r32) * KSTR + (ks * 16 + hi * 8) * 2);
                s[0] = __builtin_amdgcn_mfma_f32_32x32x16_bf16(kf, qf[0][ks], s[0], 0, 0, 0);
                s[1] = __builtin_amdgcn_mfma_f32_32x32x16_bf16(kf, qf[1][ks], s[1], 0, 0, 0);
            }
            if (c == 0 || c == 2) {
#pragma unroll
                for (int qt = 0; qt < 2; ++qt) { const int q = qloc + qt * 32 + r32;
#pragma unroll
                    for (int r = 0; r < 16; ++r) { const int j = kt * 32 + crow(r, hi); const bool ok = (c == 0) ? (j >= q) : (j <= q); if (!ok) s[qt][r] = -INFINITY; } }
            }
            bf16x8 pb[2][2];
#pragma unroll
            for (int qt = 0; qt < 2; ++qt) {
                float mx = s[qt][0];
#pragma unroll
                for (int r = 1; r < 16; ++r) mx = fmaxf(mx, s[qt][r]);
                mx = fmaxf(mx, __shfl_xor(mx, 32));
                const float mnew = fmaxf(mrow[qt], mx);
                const float alpha = __builtin_amdgcn_exp2f(mrow[qt] - mnew);
                mrow[qt] = mnew;
                float ls = 0.f;
#pragma unroll
                for (int r = 0; r < 16; ++r) { const float pv = __builtin_amdgcn_exp2f(s[qt][r] - mnew); s[qt][r] = pv; ls += pv; }
                lrow[qt] = lrow[qt] * alpha + ls;
#pragma unroll
                for (int dt = 0; dt < 2; ++dt)
#pragma unroll
                    for (int r = 0; r < 16; ++r) o[dt][qt][r] *= alpha;
#pragma unroll
                for (int st = 0; st < 2; ++st) {
                    u32x4 w; w.x = cvt_pk_bf16(s[qt][8 * st + 0], s[qt][8 * st + 1]); w.y = cvt_pk_bf16(s[qt][8 * st + 2], s[qt][8 * st + 3]);
                    w.z = cvt_pk_bf16(s[qt][8 * st + 4], s[qt][8 * st + 5]); w.w = cvt_pk_bf16(s[qt][8 * st + 6], s[qt][8 * st + 7]);
                    pb[qt][st] = __builtin_bit_cast(bf16x8, w);
                }
            }
#pragma unroll
            for (int st = 0; st < 2; ++st)
#pragma unroll
                for (int dt = 0; dt < 2; ++dt) {
                    const LAS unsigned char* vp = vb + (dt * 32 + r32) * VSTR + (kt * 32 + st * 16 + hi * 4) * 2;
                    const u32x2 lo = *(const LAS u32x2*)vp, hh = *(const LAS u32x2*)(vp + 16);
                    const bf16x8 vf = __builtin_bit_cast(bf16x8, (u32x4){lo.x, lo.y, hh.x, hh.y});
                    o[dt][0] = __builtin_amdgcn_mfma_f32_32x32x16_bf16(vf, pb[0][st], o[dt][0], 0, 0, 0);
                    o[dt][1] = __builtin_amdgcn_mfma_f32_32x32x16_bf16(vf, pb[1][st], o[dt][1], 0, 0, 0);
                }
        }
        if (cn < 5) lstore(buf ^ 1);
        __syncthreads();
        buf ^= 1; c = cn;
    }
    {
        LAS unsigned char* stg = lds + wid * 9216;
#pragma unroll
        for (int qt = 0; qt < 2; ++qt) {
            const float lt = lrow[qt] + __shfl_xor(lrow[qt], 32);
            const float inv = 1.0f / lt;
            LAS unsigned char* srow = stg + (qt * 32 + r32) * 144 + 8 * hi;
#pragma unroll
            for (int dt = 0; dt < 2; ++dt)
#pragma unroll
                for (int g = 0; g < 4; ++g) {
                    u32x2 w; w.x = cvt_pk_bf16(o[dt][qt][4 * g] * inv, o[dt][qt][4 * g + 1] * inv); w.y = cvt_pk_bf16(o[dt][qt][4 * g + 2] * inv, o[dt][qt][4 * g + 3] * inv);
                    *(LAS u32x2*)(srow + dt * 64 + 16 * g) = w;
                }
        }
        asm volatile("s_waitcnt lgkmcnt(0)" ::: "memory");
        bf16_t* obase = A.MIX + (qrow0 + qloc) * 1024 + 512 + hq * 64;
#pragma unroll
        for (int i = 0; i < 8; ++i) { const int row = i * 8 + (lane >> 3), ch = lane & 7;
            const u32x4 v = *(const LAS u32x4*)(stg + row * 144 + ch * 16);
            *(u32x4*)(obase + (size_t)row * 1024 + ch * 8) = v; }
    }
    __syncthreads();
}
}


#define XB_TMO      128
#define XB_XCNT(j)  (256  + 64 * (j))
#define XB_XSUB(j)  (1280 + 64 * (j))
#define XB_XGEN(j)  (2304 + 64 * (j))
#define XB_TOP      3328
#define XB_TOPGEN   3392
#define XCD_BAR_WORDS 3456
#define XB_SPIN_CAP (1u << 18)
__device__ __forceinline__ unsigned xb_ld(unsigned* p)              { return __hip_atomic_load(p, __ATOMIC_RELAXED, __HIP_MEMORY_SCOPE_AGENT); }
__device__ __forceinline__ unsigned xb_add(unsigned* p, unsigned v) { return __hip_atomic_fetch_add(p, v, __ATOMIC_RELAXED, __HIP_MEMORY_SCOPE_AGENT); }
__device__ __forceinline__ unsigned xb_xcc_id() { return (unsigned)__builtin_amdgcn_s_getreg((3 << 11) | 20) & 0xFu; }
#define XB_SPIN(cond, bar) do { unsigned _sp = 0; while (cond) { __builtin_amdgcn_s_sleep(1); \
    if ((++_sp & 255u) == 0u) { if (xb_ld(&(bar)[XB_TMO])) break; if (_sp > XB_SPIN_CAP) { atomicAdd(&(bar)[XB_TMO], 1u); break; } } } } while (0)
struct XcdBarrier { unsigned* bar; unsigned x; volatile LAS unsigned* st; };
__device__ __forceinline__ XcdBarrier xcd_barrier_post(unsigned* bar, volatile LAS unsigned* st) {
    XcdBarrier b; b.bar = bar; b.x = xb_xcc_id(); b.st = st;
    if (threadIdx.x == 0) (void)xb_add(&bar[XB_XCNT(b.x)], 1u);
    return b;
}
__device__ __forceinline__ void xcd_barrier_complete(unsigned* bar, unsigned x, unsigned& nloc, unsigned& nx) {
    const unsigned G = gridDim.x * gridDim.y * gridDim.z;
    unsigned sum, cnt, mine, sp = 0u;
    for (;;) {
        sum = 0u; cnt = 0u; mine = 0u;
#pragma unroll
        for (unsigned j = 0; j < 16; ++j) { const unsigned c = xb_ld(&bar[XB_XCNT(j)]); sum += c; cnt += (c > 0u) ? 1u : 0u; mine = (j == x) ? c : mine; }
        if (sum == G) break;
        __builtin_amdgcn_s_sleep(1);
        if ((++sp & 255u) == 0u) { if (xb_ld(&bar[XB_TMO])) break; if (sp > XB_SPIN_CAP) { atomicAdd(&bar[XB_TMO], 1u); break; } }
    }
    nloc = mine > 0u ? mine : 1u; nx = cnt > 0u ? cnt : 1u;
}
__device__ __forceinline__ void xcd_barrier(const XcdBarrier& b) {
    asm volatile("s_waitcnt vmcnt(0)" ::: "memory");
    __syncthreads();
    if (threadIdx.x == 0) {
        unsigned* bar = b.bar;
        __builtin_amdgcn_s_waitcnt(0);
        unsigned nloc = b.st[0], nx = b.st[1];
        if (nloc == 0u) { xcd_barrier_complete(bar, b.x, nloc, nx); b.st[0] = nloc; b.st[1] = nx; }
        const unsigned old = xb_add(&bar[XB_XSUB(b.x)], 1u);
        const unsigned gen = old / nloc;
        if (old + 1u == (gen + 1u) * nloc) {
            __builtin_amdgcn_fence(__ATOMIC_RELEASE, "agent");
            asm volatile("s_waitcnt vmcnt(0)" ::: "memory");
            const unsigned og = xb_add(&bar[XB_TOP], 1u);
            const unsigned tg = og / nx;
            if (og + 1u == (tg + 1u) * nx) xb_add(&bar[XB_TOPGEN], 1u);
            else XB_SPIN(xb_ld(&bar[XB_TOPGEN]) == tg, bar);
            __builtin_amdgcn_fence(__ATOMIC_ACQUIRE, "agent");
            xb_add(&bar[XB_XGEN(b.x)], 1u);
            asm volatile("s_waitcnt vmcnt(0)" ::: "memory");
        } else {
            XB_SPIN(xb_ld(&bar[XB_XGEN(b.x)]) == gen, bar);
            __builtin_amdgcn_fence(__ATOMIC_ACQUIRE, "agent");
            asm volatile("s_waitcnt vmcnt(0)" ::: "memory");
        }
    }
    __syncthreads();
}

struct Params {
    const float *x, *c, *ctx, *c_ctx, *ada_w, *ada_b, *norm_mix_g, *norm_ffn_g, *mix_in_w, *mix_out_w, *attn_sink, *pool_w, *pool_scale, *ffn_w1, *ffn_w3, *ffn_w2, *final_g;
    float* out; unsigned char* ws;
};

__device__ __forceinline__ void tr_item(const float* W, int spitch, int ncols, bf16_t* WT, int dpitch, int mode, int roff, const float* nscale, LAS float* scr, int item, int lane) {
    const int nblk = ncols / 32, kb = item / nblk, nb = item % nblk, k0 = 64 * kb, n0 = 32 * nb;
    float tv[32];
#pragma unroll
    for (int i = 0; i < 32; ++i) tv[i] = W[(size_t)(k0 + 2 * i + (lane >> 5)) * spitch + n0 + (lane & 31)];
#pragma unroll
    for (int i = 0; i < 32; ++i) scr[(2 * i + (lane >> 5)) * 33 + (lane & 31)] = tv[i];
    asm volatile("s_waitcnt lgkmcnt(0)" ::: "memory");
    const int c = lane & 7;
#pragma unroll
    for (int j = 0; j < 4; ++j) { const int n = (lane >> 3) + 8 * j; const LAS float* s = scr + (8 * c) * 33 + n;
        const float sc = nscale ? nscale[n0 + n] : 1.0f;
        const int gn = n0 + n; const int drow = (mode == 0) ? (roff + gn) : ((gn >> 7) * 256 + (gn & 127) + roff);
        u32x4 o; o.x = cvt_pk_bf16(s[0 * 33] * sc, s[1 * 33] * sc); o.y = cvt_pk_bf16(s[2 * 33] * sc, s[3 * 33] * sc); o.z = cvt_pk_bf16(s[4 * 33] * sc, s[5 * 33] * sc); o.w = cvt_pk_bf16(s[6 * 33] * sc, s[7 * 33] * sc);
        *(u32x4*)(WT + (size_t)drow * dpitch + k0 + 8 * c) = o; }
    asm volatile("s_waitcnt lgkmcnt(0)" ::: "memory");
}

template <class TS>
__device__ __forceinline__ void norm_pass(const TS* srcL, const TS* srcC, const float* gvec, const float* modl, int shift_off, int scale_off, bf16_t* XN, int M, int gw, int NGW, const float* slab = nullptr, const float* sgate = nullptr) {
    const int lane = opaque_tid() & 63;
    for (int row0 = gw * 4; row0 < M; row0 += NGW * 4) {
        const TS* src; int mb;
        if (row0 < NLAT) { src = srcL + (size_t)row0 * D; mb = row0 >> 12; } else { src = srcC + (size_t)(row0 - NLAT) * D; mb = 8; }
        f32x4 v[4][4];
#pragma unroll
        for (int r = 0; r < 4; ++r)
#pragma unroll
            for (int j = 0; j < 4; ++j) v[r][j] = ld4(src + (size_t)r * D + lane * 4 + 256 * j);
        if (slab && row0 >= NLAT) {
#pragma unroll
            for (int r = 0; r < 4; ++r)
#pragma unroll
                for (int j = 0; j < 4; ++j) { const float* s0 = slab + (size_t)(row0 - NLAT + r) * D + lane * 4 + 256 * j;
                    v[r][j] = v[r][j] + *(const f32x4*)(sgate + lane * 4 + 256 * j) * (*(const f32x4*)s0 + *(const f32x4*)(s0 + (size_t)NCTX * D)); } }
        float rstd[4];
#pragma unroll
        for (int r = 0; r < 4; ++r) { float ss = 0.f;
#pragma unroll
            for (int j = 0; j < 4; ++j) ss += (v[r][j].x * v[r][j].x + v[r][j].y * v[r][j].y) + (v[r][j].z * v[r][j].z + v[r][j].w * v[r][j].w);
            rstd[r] = rsqrtf(wave_sum(ss) * (1.0f / D) + EPS); }
        const float* mrow = modl + (size_t)mb * MODW;
#pragma unroll
        for (int j = 0; j < 4; ++j) { const int c = lane * 4 + 256 * j;
            const f32x4 g4 = *(const f32x4*)(gvec + c), sc4 = *(const f32x4*)(mrow + scale_off + c), sh4 = *(const f32x4*)(mrow + shift_off + c);
            const f32x4 G4 = g4 * (sc4 + 1.0f);
#pragma unroll
            for (int r = 0; r < 4; ++r) { const f32x4 q = v[r][j] * rstd[r] * G4 + sh4;
                u32x2 w; w.x = cvt_pk_bf16(q.x, q.y); w.y = cvt_pk_bf16(q.z, q.w);
                ((u32x2*)(XN + (size_t)(row0 + r) * D) + lane)[64 * j] = w; } }
    }
}

template <int HALF>
__device__ __forceinline__ void pool_rows(const f32x2 (&v)[47], f32x2 G2, int t0, int N, bf16_t* po) {
    f32x2 S = (f32x2){0.f, 0.f};
#pragma unroll
    for (int i = 8 - HALF; i < 8 + HALF; ++i) S += v[i];
#pragma unroll
    for (int t = 0; t < 32; ++t) {
        const int tt = t0 + t;
        const int lo = (tt - HALF) > 0 ? (tt - HALF) : 0, hh = (tt + HALF) < N ? (tt + HALF) : N;
        const float icnt = 1.0f / (float)(hh - lo);
        const f32x2 r = G2 * (S * icnt - v[t + 8]);
        *(unsigned*)(po + (size_t)t * D) = cvt_pk_bf16(r.x, r.y);
        if (t < 31) S += v[t + 8 + HALF] - v[t + 8 - HALF];
    }
}
struct PoolItem { int t0, N, mb; const bf16_t* base; size_t orow0; };
__device__ __forceinline__ PoolItem pool_item(int item, const bf16_t* srcL, const bf16_t* srcC) {
    PoolItem q;
    if (item < 1024) { const int seq = item >> 7; q.t0 = (item & 127) * 32; q.N = SEQ; q.base = srcL + (size_t)seq * SEQ * D; q.mb = seq; q.orow0 = (size_t)seq * SEQ; }
    else { const int it = item - 1024; const int seq = it >> 3; q.t0 = (it & 7) * 32; q.N = CTX; q.base = srcC + (size_t)seq * CTX * D; q.mb = 8; q.orow0 = (size_t)NLAT + seq * CTX; }
    return q;
}
__device__ __forceinline__ void pool_load(f32x2 (&v)[47], const PoolItem& q, int c0) {
    const bf16_t* colp = q.base + c0;
#pragma unroll
    for (int i = 0; i < 47; ++i) { const int t = q.t0 - 8 + i; v[i] = (t >= 0 && t < q.N) ? ld2(colp + (size_t)t * D) : (f32x2){0.f, 0.f}; }
}
__device__ __forceinline__ void pool_pass(const bf16_t* srcL, const bf16_t* srcC, const float* gvec, const float* modl, int scale_off, bf16_t* PO, bool with_ctx, LAS float* lds_f, int G) {
    const int tid = opaque_tid(), lane = tid & 63, wave = tid >> 6;
    LAS float* part = lds_f;
    LAS float* srs = lds_f + 8 * 48;
    const int nitems = 1024 + (with_ctx ? 64 : 0);
    int q = 0; while ((q + 1) * G <= nitems) ++q;
    const int rem = nitems - q * G, bxi = (int)blockIdx.x;
    const int i0 = bxi * q + (bxi < rem ? bxi : rem), i1 = i0 + q + (bxi < rem ? 1 : 0);
    const int c0 = 2 * tid;
    const int grp = c0 >> 8;
    const f32x2 g2 = *(const f32x2*)(gvec + c0);
    if (i0 >= i1) return;
    f32x2 v[47], vn[47];
    PoolItem cur = pool_item(i0, srcL, srcC);
    pool_load(v, cur, c0);
    for (int item = i0; item < i1; ++item) {
        PoolItem nxt = cur;
        const bool has_next = item + 1 < i1;
        if (has_next) { nxt = pool_item(item + 1, srcL, srcC); pool_load(vn, nxt, c0); }
#pragma unroll
        for (int i = 0; i < 47; ++i) { const float s = wave_sum(v[i].x * v[i].x + v[i].y * v[i].y); if (lane == 0) part[wave * 48 + i] = s; }
        __syncthreads();
        if (tid < 47) { float s = 0.f;
#pragma unroll
            for (int w = 0; w < 8; ++w) s += part[w * 48 + tid];
            srs[tid] = rsqrtf(s * (1.0f / D) + EPS); }
        __syncthreads();
#pragma unroll
        for (int i = 0; i < 47; ++i) v[i] = v[i] * srs[i];
        const f32x2 sc2 = *(const f32x2*)(modl + (size_t)cur.mb * MODW + scale_off + c0);
        const f32x2 G2 = g2 * (sc2 + 1.0f);
        bf16_t* po = PO + (cur.orow0 + cur.t0) * D + c0;
        if (grp == 0) pool_rows<1>(v, G2, cur.t0, cur.N, po);
        else if (grp == 1) pool_rows<2>(v, G2, cur.t0, cur.N, po);
        else if (grp == 2) pool_rows<4>(v, G2, cur.t0, cur.N, po);
        else pool_rows<8>(v, G2, cur.t0, cur.N, po);
        __syncthreads();
        if (has_next) {
#pragma unroll
            for (int i = 0; i < 47; ++i) v[i] = vn[i];
            cur = nxt; }
    }
}

__device__ __forceinline__ float bf2f(unsigned short h) { return __uint_as_float((unsigned)h << 16); }
__device__ __forceinline__ void fold_pass(const bf16_t* FT, bf16_t* FTF, float* A2048, bf16_t* MIXp, int gw, int NGW) {
    const int lane = opaque_tid() & 63;
    for (int r = gw; r < 4096; r += NGW) {
        const bf16_t* a = FT + (size_t)r * 8192; bf16_t* o = FTF + (size_t)r * 4096;
        bf16x8 lo[2][4], mi[2][4]; unsigned short m0[2][4];
        const unsigned short a2048 = a[2048];
#pragma unroll
        for (int part = 0; part < 2; ++part)
#pragma unroll
            for (int j = 0; j < 4; ++j) { const bf16_t* s = a + part * 4096; const int n0 = 8 * (lane + 64 * j);
                lo[part][j] = *(const bf16x8*)(s + n0);
                mi[part][j] = *(const bf16x8*)(s + 4096 - n0 - 8);
                m0[part][j] = s[(n0 > 0) ? (4096 - n0) : 0]; }
        asm volatile("" ::: "memory");
        float alt = 0.f;
#pragma unroll
        for (int part = 0; part < 2; ++part) { const float sg = part ? -1.0f : 1.0f;
#pragma unroll
            for (int j = 0; j < 4; ++j) { const int n0 = 8 * (lane + 64 * j);
                float v[8];
                v[0] = bf2f((unsigned short)lo[part][j][0]) + sg * bf2f(m0[part][j]);
#pragma unroll
                for (int e = 1; e < 8; ++e) v[e] = bf2f((unsigned short)lo[part][j][e]) + sg * bf2f((unsigned short)mi[part][j][8 - e]);
                if (n0 == 0) v[0] = part ? bf2f(a2048) : bf2f((unsigned short)lo[part][j][0]);
                if (part == 0) alt += ((v[0] - v[1]) + (v[2] - v[3])) + ((v[4] - v[5]) + (v[6] - v[7]));
                u32x4 w; w.x = cvt_pk_bf16(v[0], v[1]); w.y = cvt_pk_bf16(v[2], v[3]); w.z = cvt_pk_bf16(v[4], v[5]); w.w = cvt_pk_bf16(v[6], v[7]);
                *(u32x4*)(o + part * 2048 + n0) = w; } }
        alt = wave_sum(alt);
        if (lane == 0) { const float a2 = bf2f(a2048) * (1.0f / 64.0f); A2048[r] = a2;
            MIXp[((size_t)(r >> 9) * SEQ + 2048) * 1024 + (r & 511)] = (bf16_t)(cvt_pk_bf16(alt * (1.0f / 64.0f) + a2, 0.f) & 0xffffu); }
    }
}

__device__ __forceinline__ void ffn_weights_convert(const Params& p, bf16_t* W13, bf16_t* W2, int l_lo, int l_hi, int widx, int nw, LAS float* scr) {
    const int lane = opaque_tid() & 63;
    constexpr int I_W = 16 * 88, I_2 = 44 * 32, I_L = 2 * I_W + I_2;
    const int n = (l_hi - l_lo) * I_L;
    for (int it = widx; it < n; it += nw) {
        const int l = l_lo + it / I_L; const int r = it % I_L;
        if (r < I_W) tr_item(p.ffn_w1 + (size_t)l * D * FF, FF, FF, W13 + (size_t)l * W13_L, D, 1, 0, nullptr, scr, r, lane);
        else if (r < 2 * I_W) tr_item(p.ffn_w3 + (size_t)l * D * FF, FF, FF, W13 + (size_t)l * W13_L, D, 1, 128, nullptr, scr, r - I_W, lane);
        else tr_item(p.ffn_w2 + (size_t)l * FF * D, D, D, W2 + (size_t)l * W2_L, FF, 0, 0, nullptr, scr, r - 2 * I_W, lane);
    }
}

__global__ void __launch_bounds__(512, 2) fwd_kernel(Params p) {
    extern __shared__ __attribute__((aligned(16))) unsigned char lds_raw[];
    LAS unsigned char* lds = (LAS unsigned char*)lds_raw;
    cg::grid_group grid = cg::this_grid();
    const int tid = threadIdx.x, lane = tid & 63, wave = __builtin_amdgcn_readfirstlane(tid >> 6);
    const int G = gridDim.x, bx = blockIdx.x;
    const int vcu = (G % 8 == 0) ? (bx % 8) * (G / 8) + bx / 8 : bx;
    const int gw = vcu * 8 + wave, NGW = G * 8;
    const int gtid = bx * 512 + tid, NT = G * 512;
    unsigned char* ws = p.ws;
    volatile LAS unsigned* bst = (volatile LAS unsigned*)(lds + 131072 + 1024);
    if (tid < 2) bst[tid] = 0u;
    __syncthreads();
    XcdBarrier xbar = xcd_barrier_post((unsigned*)(ws + WS_BAR), bst);
    float* MOD = (float*)(ws + WS_MOD); float* ROPE = (float*)(ws + WS_ROPE); bf16_t* DFT256 = (bf16_t*)(ws + WS_DFT256); bf16_t* HC = (bf16_t*)(ws + WS_HC); bf16_t* HB = (bf16_t*)(ws + WS_HB);
    bf16_t* DFT = (bf16_t*)(ws + WS_DFT); bf16_t* XN = (bf16_t*)(ws + WS_XN);
    bf16_t* W13 = (bf16_t*)(ws + WS_W13); bf16_t* W2 = (bf16_t*)(ws + WS_W2); bf16_t* WQKV = (bf16_t*)(ws + WS_WQKV); bf16_t* WF = (bf16_t*)(ws + WS_WF); bf16_t* WO = (bf16_t*)(ws + WS_WO); bf16_t* WP = (bf16_t*)(ws + WS_WP);
    bf16_t* U = (bf16_t*)(ws + WS_U); bf16_t* Qb = (bf16_t*)(ws + WS_Q); bf16_t* Kb = (bf16_t*)(ws + WS_K);
    float* A2048 = (float*)(ws + WS_DFT256 + 512 * 1024);
    bf16_t* FTF = (bf16_t*)(ws + WS_FTF); bf16_t* FT = (bf16_t*)(ws + WS_FT); bf16_t* FTc = (bf16_t*)(ws + WS_FTC); bf16_t* MIX = (bf16_t*)(ws + WS_MIX);

    {
        LAS float* sS = (LAS float*)lds;
        LAS float* sR = (LAS float*)(lds + 9 * 1024 * 4);
        for (int idx = tid; idx < 9 * 1024; idx += 512) { const int r = idx >> 10, k = idx & 1023; const float v = r < 8 ? p.c[r * 1024 + k] : p.c_ctx[k]; sS[idx] = v / (1.0f + __expf(-v)); }
        __syncthreads();
        for (int item = bx; item < 4 * 96; item += G) {
            const int layer = item / 96, j0 = (item % 96) * 64;
            const float* W = p.ada_w + (size_t)layer * D * MODW + j0 + lane;
            float a0 = 0.f, a1 = 0.f, a2 = 0.f, a3 = 0.f, a4 = 0.f, a5 = 0.f, a6 = 0.f, a7 = 0.f, a8 = 0.f;
#pragma unroll 1
            for (int kb = 0; kb < 128; kb += 32) {
                float wv[32];
#pragma unroll
                for (int e = 0; e < 32; ++e) wv[e] = W[(size_t)(wave * 128 + kb + e) * MODW];
#pragma unroll
                for (int e = 0; e < 32; ++e) { const int k = wave * 128 + kb + e;
                    a0 += sS[k] * wv[e]; a1 += sS[1024 + k] * wv[e]; a2 += sS[2048 + k] * wv[e]; a3 += sS[3072 + k] * wv[e]; a4 += sS[4096 + k] * wv[e];
                    a5 += sS[5120 + k] * wv[e]; a6 += sS[6144 + k] * wv[e]; a7 += sS[7168 + k] * wv[e]; a8 += sS[8192 + k] * wv[e]; } }
            LAS float* rr = sR + wave * 9 * 64 + lane;
            rr[0] = a0; rr[64] = a1; rr[128] = a2; rr[192] = a3; rr[256] = a4; rr[320] = a5; rr[384] = a6; rr[448] = a7; rr[512] = a8;
            __syncthreads();
            for (int o = tid; o < 576; o += 512) { const int r = o >> 6, l = o & 63; float s = 0.f;
#pragma unroll
                for (int w = 0; w < 8; ++w) s += sR[(w * 9 + r) * 64 + l];
                MOD[((size_t)layer * 9 + r) * MODW + j0 + l] = s + p.ada_b[(size_t)layer * MODW + j0 + l]; }
            __syncthreads();
        }
        {
            LAS float* wt = (LAS float*)lds;
            LAS float* tc = (LAS float*)(lds + 32 * 129 * 4);
            for (int item = bx; item < 256; item += G) {
                const int j = item >> 7, h = (item >> 5) & 3, k0 = (item & 31) * 32;
                __syncthreads();
                if (tid < 128) { const float t = (float)tid * (1.0f / 128.0f); tc[tid] = __builtin_amdgcn_cosf(t); tc[128 + tid] = __builtin_amdgcn_sinf(t); }
                for (int idx = tid; idx < 32 * 128; idx += 512) { const int kk = idx >> 7, i = idx & 127; wt[kk * 129 + i] = p.mix_in_w[((size_t)j * D + k0 + kk) * 1280 + h * 128 + i]; }
                __syncthreads();
                const int jj = tid & 127, kq = tid >> 7;
                float ac[8], as[8];
#pragma unroll
                for (int e = 0; e < 8; ++e) { ac[e] = 0.f; as[e] = 0.f; }
                for (int i = 0; i < 128; ++i) { const int ph = (i * jj) & 127; const float cv = tc[ph], sv = tc[128 + ph];
#pragma unroll
                    for (int e = 0; e < 8; ++e) { const float w = wt[(kq * 8 + e) * 129 + i]; ac[e] += w * cv; as[e] += w * sv; } }
                const float nrm = 0.08838834764831845f;
                u32x4 oc, os;
                oc.x = cvt_pk_bf16(ac[0] * nrm, ac[1] * nrm); oc.y = cvt_pk_bf16(ac[2] * nrm, ac[3] * nrm); oc.z = cvt_pk_bf16(ac[4] * nrm, ac[5] * nrm); oc.w = cvt_pk_bf16(ac[6] * nrm, ac[7] * nrm);
                os.x = cvt_pk_bf16(as[0] * nrm, as[1] * nrm); os.y = cvt_pk_bf16(as[2] * nrm, as[3] * nrm); os.z = cvt_pk_bf16(as[4] * nrm, as[5] * nrm); os.w = cvt_pk_bf16(as[6] * nrm, as[7] * nrm);
                bf16_t* dst = WF + (size_t)j * WF_L + (size_t)(h * 128 + jj) * D + k0 + kq * 8;
                *(u32x4*)dst = oc; *(u32x4*)(dst + (size_t)512 * D) = os;
            }
            __syncthreads();
        }
        {
            LAS float* scr = (LAS float*)(lds + wave * 8448);
            constexpr int I_QKV = 16 * 24, I_O = 16 * 32, I_E = I_QKV + I_O, I_P = 4 * 32;
            constexpr int NITEMS = 2 * I_E + 2 * I_P;
            ffn_weights_convert(p, W13, W2, 0, 1, gw, NGW, scr);
            for (int it = gw; it < NITEMS; it += NGW) {
                int r = it;
                if (r < 2 * I_E) { const int j = r / I_E; r -= j * I_E;
                    if (r < I_QKV) tr_item(p.mix_in_w + (size_t)j * D * 1280 + 512, 1280, 768, WQKV + (size_t)j * WQKV_L, D, 0, 0, nullptr, scr, r, lane);
                    else tr_item(p.mix_out_w + (size_t)j * D * D, D, D, WO + (size_t)j * WO_L, D, 0, 0, nullptr, scr, r - I_QKV, lane);
                    continue; }
                r -= 2 * I_E;
                { const int j = r / I_P; r -= j * I_P; const int gq = r / 32; r -= gq * 32;
                  tr_item(p.pool_w + ((size_t)j * 4 + gq) * 65536, 256, 256, WP + (size_t)j * WP_L + (size_t)gq * 65536, 256, 0, 0, p.pool_scale + (size_t)j * D + gq * 256, scr, r, lane); }
            }
        }
        for (int idx = gtid; idx < 2048 * 512; idx += NT) {
            const int k = idx >> 9, n0 = (idx & 511) * 8;
            float v[8];
#pragma unroll
            for (int e = 0; e < 8; ++e) { const int np = n0 + e; float r;
                if (np < 2048) r = __builtin_amdgcn_cosf((float)((k * np) & 4095) * (1.0f / 4096.0f));
                else if (np == 2048) r = (k & 1) ? -1.0f : 1.0f;
                else r = -__builtin_amdgcn_sinf((float)((k * (np - 2048)) & 4095) * (1.0f / 4096.0f));
                v[e] = r * (1.0f / 64.0f); }
            u32x4 o; o.x = cvt_pk_bf16(v[0], v[1]); o.y = cvt_pk_bf16(v[2], v[3]); o.z = cvt_pk_bf16(v[4], v[5]); o.w = cvt_pk_bf16(v[6], v[7]);
            *(u32x4*)(DFT + (size_t)k * 4096 + n0) = o;
        }
        for (int idx = gtid; idx < 256 * 64; idx += NT) {
            const int k = idx >> 6, n0 = (idx & 63) * 8; const bool sp = n0 >= 256; const int nn = n0 & 255;
            float v[8];
#pragma unroll
            for (int e = 0; e < 8; ++e) { const float t = (float)((k * (nn + e)) & 255) * (1.0f / 256.0f); v[e] = (sp ? -__builtin_amdgcn_sinf(t) : __builtin_amdgcn_cosf(t)) * (1.0f / 16.0f); }
            u32x4 o; o.x = cvt_pk_bf16(v[0], v[1]); o.y = cvt_pk_bf16(v[2], v[3]); o.z = cvt_pk_bf16(v[4], v[5]); o.w = cvt_pk_bf16(v[6], v[7]);
            *(u32x4*)(DFT256 + (size_t)k * 512 + n0) = o;
        }
        for (int idx = gtid; idx < 64 * 16; idx += NT) {
            const int pos = idx >> 4, f = idx & 15;
            const float inv = exp2f(-(float)f * (13.287712379549449f / 16.0f));
            const float turns = (float)pos * inv * 0.15915494309189535f;
            const float fr = turns - floorf(turns);
            ROPE[2 * idx] = __builtin_amdgcn_cosf(fr); ROPE[2 * idx + 1] = __builtin_amdgcn_sinf(fr);
        }
    }
    grid.sync();

    for (int layer = 0; layer < DEPTH; ++layer) {
        const float* modl = MOD + (size_t)layer * 9 * MODW;
        const int jj = layer >> 1;
        const bool upd_ctx = layer < 2;
        if ((layer & 1) == 0) {
            const int Mrows = MALL;
            if (layer == 0) norm_pass(p.x, p.ctx, p.norm_mix_g + (size_t)layer * D, modl, 0, D, XN, Mrows, gw, NGW);
            else norm_pass(HB, HC, p.norm_mix_g + (size_t)layer * D, modl, 0, D, XN, Mrows, gw, NGW, (const float*)(ws + WS_SLAB), MOD + ((size_t)1 * 9 + 8) * MODW + 5 * D);
            xcd_barrier(xbar);
            { pg8::Gemm g{XN, WQKV + (size_t)jj * WQKV_L, D, D, D, 0, 0}; pg8::Order S(Mrows / 256, 3, 1, G, vcu, 3);
              pg8::EpiQKV E{Qb, Kb, ROPE}; pg8::gemm_phase(lds, g, S, E); }
            { const int ntok = upd_ctx ? MALL : NLAT;
              pg8::Gemm g{WF + (size_t)jj * WF_L, XN, D, D, D, 0, 0}; pg8::Order S(4, ntok / 256, 1, G, G - 1 - vcu, 2);
              pg8::EpiFT E{FT, FTc}; pg8::gemm_phase(lds, g, S, E); }
            xcd_barrier(xbar);
            if (upd_ctx && G > 32) { if (vcu >= 32) fold_pass(FT, FTF, A2048, MIX, (vcu - 32) * 8 + wave, (G - 32) * 8); }
            else fold_pass(FT, FTF, A2048, MIX, gw, NGW);
            { att::Args A{Qb, Kb, MIX, p.attn_sink + jj * 8};
              const int nun = 512 + (upd_ctx ? 32 : 0);
              for (int un = vcu; un < nun; un += G) {
                  int b, blk, kvh;
                  if (un < 512) { b = un >> 6; blk = (un >> 1) & 31; kvh = un & 1; } else { const int q = un - 512; b = q >> 2; blk = 32 + ((q >> 1) & 1); kvh = q & 1; }
                  att::unit(lds, A, b, blk, kvh);
              } }
            xcd_barrier(xbar);
            { pg8::Gemm g{DFT, FTF, 2048, 4096, 4096, 0, (long)512 * 4096, 4096, 4096, (long)128 * 4096 * 2, (long)128 * 4096 * 2};
              pg8::Order S(16, 4, 8, G, vcu, 3);
              pg8::EpiDftSym E{MIX, A2048}; pg8::gemm_phase<pg8::EpiDftSym, true>(lds, g, S, E); }
            if (upd_ctx) { pg8::Gemm g{DFT256, FTc, 512, 512, 512, 0, (long)512 * 512}; pg8::Order S(1, 2, 8, G, vcu, 0);
              pg8::EpiStore E{MIX + (size_t)NLAT * 1024, 1024, (long)CTX * 1024}; pg8::gemm_phase(lds, g, S, E); }
            xcd_barrier(xbar);
            { const int Mo = upd_ctx ? MALL : NLAT;
              pg8::Gemm g{MIX, WO + (size_t)jj * WO_L, D, D, D, 0, 0}; pg8::Order S(Mo / 256, 4, 1, G, vcu, 3);
              if (layer == 0) { pg8::EpiResH<float> E{p.x, p.ctx, HB, HC, modl + 2 * D, 0}; pg8::gemm_phase(lds, g, S, E); }
              else { pg8::EpiResH<bf16_t> E{HB, HC, HB, HC, modl + 2 * D, 0}; pg8::gemm_phase(lds, g, S, E); } }
            xcd_barrier(xbar);
        } else {
            pool_pass(HB, HC, p.norm_mix_g + (size_t)layer * D, modl, D, MIX, upd_ctx, (LAS float*)lds, G);
            xcd_barrier(xbar);
            { const int Mo = upd_ctx ? MALL : NLAT;
              pg8::Gemm g{MIX, WP + (size_t)jj * WP_L, 256, D, 256, 256, 65536}; pg8::Order S(Mo / 256, 1, 4, G, vcu, 3, 1);
              pg8::EpiResH<bf16_t> E{HB, HC, HB, HC, modl + 2 * D, 256}; pg8::gemm_phase(lds, g, S, E); }
            xcd_barrier(xbar);
        }
        const int Mf = upd_ctx ? MALL : NLAT;
        norm_pass(HB, HC, p.norm_ffn_g + (size_t)layer * D, modl, 3 * D, 4 * D, XN, Mf, gw, NGW);
        xcd_barrier(xbar);
        { pg8::Gemm g{XN, W13 + (size_t)layer * W13_L, D, D, D, 0, 0}; pg8::Order S(Mf / 256, 22, 1, G, vcu, 3);
          pg8::EpiSwiGLU E{U}; pg8::gemm_phase(lds, g, S, E); }
        xcd_barrier(xbar);
        { pg8::Gemm g{U, W2 + (size_t)layer * W2_L, FF, FF, FF, 0, 0}; pg8::Order S(NLAT / 256, 4, 1, G, vcu, 3);
          pg8::EpiResH<bf16_t> E{HB, HC, HB, HC, modl + 5 * D, 0}; pg8::gemm_phase(lds, g, S, E); }
        if (upd_ctx) {
            float* SL = (float*)(ws + WS_SLAB);
            { pg8::Gemm g{U + (size_t)NLAT * FF, W2 + (size_t)layer * W2_L, FF / 2, FF, FF, FF / 2, FF / 2}; pg8::Order S(NCTX / 256, 4, 2, G, vcu, 3);
              pg8::EpiPartial E{SL, (long)NCTX * D}; pg8::gemm_phase(lds, g, S, E); }
            { const int cb = (G > 64) ? 64 : 0;
              if (vcu >= cb) ffn_weights_convert(p, W13, W2, layer == 0 ? 1 : 2, layer == 0 ? 2 : 4, (vcu - cb) * 8 + wave, (G - cb) * 8, (LAS float*)(lds + wave * 8448)); }
            if (layer == 0) {
            xcd_barrier(xbar);
            { const int lane_c = opaque_tid() & 63; const float* g2 = modl + (size_t)8 * MODW + 5 * D;
              for (int row = gw; row < NCTX; row += NGW) {
                  bf16_t* hr = HC + (size_t)row * D + lane_c * 4; const f32x4* s0 = (const f32x4*)(SL + (size_t)row * D) + lane_c; const f32x4* s1 = s0 + (size_t)NCTX * D / 4;
                  f32x4 hv[4], sa[4], sb[4];
#pragma unroll
                  for (int j = 0; j < 4; ++j) { hv[j] = ld4(hr + 256 * j); sa[j] = s0[64 * j]; sb[j] = s1[64 * j]; }
                  asm volatile("" ::: "memory");
#pragma unroll
                  for (int j = 0; j < 4; ++j) { const f32x4 o = hv[j] + *(const f32x4*)(g2 + lane_c * 4 + 256 * j) * (sa[j] + sb[j]);
                      u32x2 w; w.x = cvt_pk_bf16(o.x, o.y); w.y = cvt_pk_bf16(o.z, o.w); *(u32x2*)(hr + 256 * j) = w; } } }
            }
        }
        xcd_barrier(xbar);
    }
    { const int lane_f = opaque_tid() & 63;
      f32x4 g4[4];
#pragma unroll
      for (int j = 0; j < 4; ++j) g4[j] = *(const f32x4*)(p.final_g + lane_f * 4 + 256 * j);
      for (int row0 = gw * 4; row0 < NLAT; row0 += NGW * 4) {
        f32x4* xr = (f32x4*)(p.out + (size_t)row0 * D) + lane_f;
        f32x4 v[4][4];
#pragma unroll
        for (int r = 0; r < 4; ++r)
#pragma unroll
            for (int j = 0; j < 4; ++j) v[r][j] = ld4(HB + (size_t)(row0 + r) * D + lane_f * 4 + 256 * j);
#pragma unroll
        for (int r = 0; r < 4; ++r) { float ss = 0.f;
#pragma unroll
            for (int j = 0; j < 4; ++j) ss += (v[r][j].x * v[r][j].x + v[r][j].y * v[r][j].y) + (v[r][j].z * v[r][j].z + v[r][j].w * v[r][j].w);
            const float rstd = rsqrtf(wave_sum(ss) * (1.0f / D) + EPS);
#pragma unroll
            for (int j = 0; j < 4; ++j) xr[r * (D / 4) + 64 * j] = v[r][j] * rstd * g4[j]; }
      } }
}

extern "C" void kernel_launch(void* const* d_in, const int* in_sizes, int n_in, void* d_out, int out_size, void* d_ws, size_t ws_size, hipStream_t stream) {
    static int grid_blocks = 0;
    if (grid_blocks == 0) {
        if (n_in != 17 || ws_size < WS_END) { fprintf(stderr, "kernel_launch: unexpected inputs (n_in %d, ws %zu)\n", n_in, ws_size); grid_blocks = -1; return; }
        int dev = 0, cus = 0, per_cu = 0;
        hipGetDevice(&dev);
        hipDeviceGetAttribute(&cus, hipDeviceAttributeMultiprocessorCount, dev);
        hipFuncSetAttribute((const void*)fwd_kernel, hipFuncAttributeMaxDynamicSharedMemorySize, LDS_BYTES);
        hipOccupancyMaxActiveBlocksPerMultiprocessor(&per_cu, (const void*)fwd_kernel, 512, LDS_BYTES);
        if (per_cu < 1) { fprintf(stderr, "kernel_launch: occupancy query gave %d\n", per_cu); per_cu = 1; }
        (void)hipGetLastError();
        grid_blocks = cus;
    }
    if (grid_blocks < 0) return;
    (void)hipMemsetAsync((unsigned char*)d_ws + WS_BAR, 0, BAR_BYTES, stream);
    Params p{};
    const float** pf = (const float**)&p;
    for (int i = 0; i < 17; ++i) pf[i] = (const float*)d_in[i];
    p.out = (float*)d_out; p.ws = (unsigned char*)d_ws;
    void* args[] = {&p};
    hipError_t e = hipLaunchCooperativeKernel((const void*)fwd_kernel, dim3(grid_blocks), dim3(512), args, LDS_BYTES, stream);
    if (e != hipSuccess) fprintf(stderr, "cooperative launch failed: %s (grid %d)\n", hipGetErrorString(e), grid_blocks);
}
```

```cpp
#include <hip/hip_runtime.h>
#include <hip/hip_cooperative_groups.h>
#include <cstdio>
#include <cstdint>
namespace cg = cooperative_groups;

#define LAS __attribute__((address_space(3)))
typedef unsigned short bf16_t;
typedef short bf16x8 __attribute__((ext_vector_type(8)));
typedef short s16x4 __attribute__((ext_vector_type(4)));
typedef float f32x4 __attribute__((ext_vector_type(4)));
typedef float f32x2 __attribute__((ext_vector_type(2)));
typedef float f32x16 __attribute__((ext_vector_type(16)));
typedef unsigned u32x4 __attribute__((ext_vector_type(4)));
typedef unsigned u32x2 __attribute__((ext_vector_type(2)));

constexpr int D = 1024, NB = 8, SEQ = 4096, NLAT = NB * SEQ, CTX = 256, NCTX = NB * CTX, MALL = NLAT + NCTX, FF = 2816, DEPTH = 4;
constexpr int MODW = 6 * D;
constexpr float EPS = 1e-6f;
constexpr float QSCALE = 0.125f * 1.4426950408889634f;
constexpr float LOG2E = 1.4426950408889634f;

constexpr size_t MiB = 1u << 20;
constexpr size_t WS_MOD = 0, WS_ROPE = 1 * MiB, WS_DFT256 = 2 * MiB, WS_HC = 3 * MiB, WS_HB = 11 * MiB, WS_XN = 75 * MiB;
constexpr size_t WS_W13 = 143 * MiB, WS_W2 = 187 * MiB, WS_WQKV = 209 * MiB, WS_WF = 212 * MiB, WS_WO = 216 * MiB, WS_WP = 220 * MiB;
constexpr size_t WS_U = 221 * MiB;
constexpr size_t WS_Q = 221 * MiB, WS_K = 255 * MiB, WS_VT = 264 * MiB, WS_VTC = 272 * MiB, WS_FT = 273 * MiB, WS_FTC = 337 * MiB, WS_MIX = 341 * MiB;
constexpr size_t WS_FTF = 410 * MiB;
constexpr size_t WS_SLAB = 442 * MiB;
constexpr size_t WS_DFT = 458 * MiB;
constexpr size_t WS_END = 490 * MiB;
constexpr size_t WS_BAR = 1 * MiB + 512 * 1024, BAR_BYTES = 16384;
constexpr size_t W13_L = (size_t)2 * FF * D, W2_L = (size_t)D * FF, WQKV_L = (size_t)768 * D, WF_L = (size_t)1024 * D, WO_L = (size_t)D * D, WP_L = (size_t)4 * 256 * 256;

constexpr int LDS_BYTES = 147456;

__device__ __forceinline__ unsigned cvt_pk_bf16(float lo, float hi) { unsigned r; asm volatile("v_cvt_pk_bf16_f32 %0, %1, %2" : "=v"(r) : "v"(lo), "v"(hi)); return r; }
__device__ __forceinline__ float wave_sum(float v) {
#pragma unroll
    for (int o = 1; o < 64; o <<= 1) v += __shfl_xor(v, o);
    return v;
}
__device__ __forceinline__ int opaque_tid() { int t = threadIdx.x; asm volatile("" : "+v"(t)); return t; }
__device__ __forceinline__ f32x4 ld4(const float* p) { return *(const f32x4*)p; }
__device__ __forceinline__ f32x4 ld4(const bf16_t* p) { const u32x2 w = *(const u32x2*)p; return (f32x4){__uint_as_float(w.x << 16), __uint_as_float(w.x & 0xffff0000u), __uint_as_float(w.y << 16), __uint_as_float(w.y & 0xffff0000u)}; }
__device__ __forceinline__ f32x2 ld2(const float* p) { return *(const f32x2*)p; }
__device__ __forceinline__ f32x2 ld2(const bf16_t* p) { const unsigned w = *(const unsigned*)p; return (f32x2){__uint_as_float(w << 16), __uint_as_float(w & 0xffff0000u)}; }
__device__ __forceinline__ float silu_f(float x) { return x * __builtin_amdgcn_rcpf(1.0f + __expf(-x)); }
__device__ __forceinline__ void silu_mul8(f32x4 a0, f32x4 b0, f32x4 a1, f32x4 b1, f32x4& o0, f32x4& o1) {
    const f32x4 t0 = a0 * (-1.4426950408889634f), t1 = a1 * (-1.4426950408889634f);
    f32x4 e0, e1;
#pragma unroll
    for (int j = 0; j < 4; ++j) { e0[j] = __builtin_amdgcn_exp2f(t0[j]); e1[j] = __builtin_amdgcn_exp2f(t1[j]); }
    const f32x4 d0 = e0 + 1.0f, d1 = e1 + 1.0f;
    f32x4 r0, r1;
#pragma unroll
    for (int j = 0; j < 4; ++j) { r0[j] = __builtin_amdgcn_rcpf(d0[j]); r1[j] = __builtin_amdgcn_rcpf(d1[j]); }
    o0 = (a0 * b0) * r0; o1 = (a1 * b1) * r1;
}

namespace pg8 {
constexpr int BM = 256, BK = 64, HALF = 128, HTB = HALF * BK * 2, STAGE_BYTES = 8 * HTB, WGM = 8;
__device__ __forceinline__ int lds_byte(int r, int c) { const int st = (r >> 4) * 2 + (c >> 5), rr = r & 15, cc = c & 31, ob = rr * 64 + cc * 2; return st * 1024 + (ob ^ (((ob >> 9) & 1) << 5)); }
__device__ __forceinline__ void stage_rc(int b, int& R, int& C) { const int st = b / 1024, sb = b % 1024, swz = sb ^ (((sb >> 9) & 1) << 5); R = (st >> 1) * 16 + swz / 64; C = (st & 1) * 32 + (swz % 64) / 2; }
__device__ __forceinline__ int perm32(int rho) { const int n = rho >> 4, i = rho & 15; return 8 * (i >> 2) + 4 * n + (i & 3); }

struct Unit { int pm, pn, z; };
struct Gemm { const bf16_t* A; const bf16_t* Bt; int K, lda, ldb; long sA, sB; long hsA = 0, hsB = 0, tsA = 0, tsB = 0; };

struct Order {
    int nN, nZ, per, G, vcu, gsh, zfast; unsigned nig, inv;
    __device__ __forceinline__ Order(int nM_, int nN_, int nZ_, int G_, int vcu_, int gsh_, int zfast_ = 0) {
        nN = nN_; nZ = nZ_; per = nM_ * nN_; G = G_; vcu = vcu_; gsh = gsh_; zfast = zfast_; nig = (unsigned)nN_ << gsh_;
        inv = (unsigned)__builtin_amdgcn_readfirstlane((int)((1u << 24) / nig + 1u));
    }
    __device__ __forceinline__ bool next(int i, Unit& u) const {
        const unsigned L = (unsigned)i * (unsigned)G + (unsigned)vcu;
        if (L >= (unsigned)per * (unsigned)nZ) return false;
        unsigned z, w;
        if (nZ == 1) { z = 0u; w = L; }
        else if (zfast) { z = L % (unsigned)nZ; w = L / (unsigned)nZ; }
        else { z = L / (unsigned)per; w = L - z * (unsigned)per; }
        const unsigned gid = (w * inv) >> 24, r = w - gid * nig;
        u.pm = (int)((gid << gsh) + (r & ((1u << gsh) - 1u))); u.pn = (int)(r >> gsh); u.z = (int)z; return true;
    }
};

template <class Epi, bool DIAG = false>
__device__ __forceinline__ void gemm_phase(LAS unsigned char* lds, const Gemm g, const Order& S, const Epi& E) {
    const int tid = opaque_tid(), wid = __builtin_amdgcn_readfirstlane(tid >> 6), lane = tid & 63, wr = wid >> 2, wc = wid & 3, fr = lane & 15, fq = lane >> 4;
    const int K = g.K, nt = K / BK;
    unsigned voffA[2], voffB[2];
#pragma unroll
    for (int i = 0; i < 2; ++i) { int R, C; stage_rc(tid * 16 + i * 8192, R, C); const int Rb = Epi::PERM ? ((R & ~31) + perm32(R & 31)) : R;
        voffA[i] = (unsigned)(R * g.lda + C) * 2u; voffB[i] = (unsigned)(Rb * g.ldb + C) * 2u; }
    const size_t kstep = (size_t)(BK * 2);
    const size_t hstepA = g.hsA ? (size_t)g.hsA : (size_t)HALF * g.lda * 2, hstepB = g.hsB ? (size_t)g.hsB : (size_t)HALF * g.ldb * 2;
    const size_t tstepA = g.tsA ? (size_t)g.tsA : 2 * hstepA, tstepB = g.tsB ? (size_t)g.tsB : 2 * hstepB;
    const unsigned ldsw = (unsigned)wid * 1024u;
    const int aoff = lds_byte(wr * 64 + fr, fq * 8), boff = lds_byte(wc * 32 + fr, fq * 8);
#define PG8_SA(b, h) (((b) * 2 + (h)) * HTB)
#define PG8_SB(b, h) ((4 + (b) * 2 + (h)) * HTB)
#define PG8_STAGE(bufoff, gbase, voff) do { _Pragma("unroll") for (int _i = 0; _i < 2; ++_i) \
        __builtin_amdgcn_global_load_lds((const unsigned*)((const char*)(gbase) + (voff)[_i]), (LAS unsigned*)(lds + (bufoff) + ldsw + _i * 8192), 16, 0, 0); } while (0)
#define PG8_LDA(dst, b, h) do { _Pragma("unroll") for (int m = 0; m < 4; ++m) _Pragma("unroll") for (int k = 0; k < 2; ++k) dst[m][k] = *(const LAS bf16x8*)(lds + PG8_SA(b, h) + aoff + m * 2048 + k * 1024); } while (0)
#define PG8_LDB(dst, b, h) do { _Pragma("unroll") for (int n = 0; n < 2; ++n) _Pragma("unroll") for (int k = 0; k < 2; ++k) dst[n][k] = *(const LAS bf16x8*)(lds + PG8_SB(b, h) + boff + n * 2048 + k * 1024); } while (0)
#define PG8_MMA(ai, bj, At, Bt) do { __builtin_amdgcn_s_setprio(1); _Pragma("unroll") for (int m = 0; m < 4; ++m) _Pragma("unroll") for (int n = 0; n < 2; ++n) _Pragma("unroll") for (int k = 0; k < 2; ++k) \
        acc[ai][bj][m][n] = __builtin_amdgcn_mfma_f32_16x16x32_bf16(Bt[n][k], At[m][k], acc[ai][bj][m][n], 0, 0, 0); __builtin_amdgcn_s_setprio(0); } while (0)
#define PG8_WAIT_V(n) asm volatile("s_waitcnt vmcnt(" #n ")" ::: "memory")
#define PG8_WAIT_L(n) asm volatile("s_waitcnt lgkmcnt(" #n ")" ::: "memory")
#define PG8_BAR __builtin_amdgcn_s_barrier()
#define PG8_SCHED __builtin_amdgcn_sched_barrier(0)
#define PG8_UA(u) ((const char*)g.A + ((size_t)(u).z * (size_t)g.sA) * 2 + (size_t)(u).pm * tstepA)
#define PG8_UB(u) ((const char*)g.Bt + ((size_t)(u).z * (size_t)g.sB) * 2 + (size_t)(u).pn * tstepB)
    Unit cur, nxt; int ui = 0;
    if (!S.next(0, cur)) return;
    f32x4 acc[2][2][4][2];
#pragma unroll
    for (int a = 0; a < 2; ++a)
#pragma unroll
        for (int b = 0; b < 2; ++b)
#pragma unroll
            for (int m = 0; m < 4; ++m)
#pragma unroll
                for (int n = 0; n < 2; ++n) acc[a][b][m][n] = (f32x4){0.f, 0.f, 0.f, 0.f};
    bf16x8 At[4][2], B0[2][2], B1[2][2];
    const char* cA = PG8_UA(cur); const char* cB = PG8_UB(cur);
    PG8_STAGE(PG8_SB(0, 0), cB, voffB); PG8_STAGE(PG8_SB(0, 1), cB + hstepB, voffB); PG8_STAGE(PG8_SA(0, 0), cA, voffA); PG8_STAGE(PG8_SA(0, 1), cA + hstepA, voffA);
    if (wr == 1) PG8_BAR;
    PG8_WAIT_V(2); PG8_BAR;
    PG8_STAGE(PG8_SB(1, 0), cB + kstep, voffB); PG8_STAGE(PG8_SA(1, 0), cA + kstep, voffA); PG8_STAGE(PG8_SB(1, 1), cB + hstepB + kstep, voffB);
    PG8_WAIT_V(6); PG8_BAR;
    for (;;) {
        const bool has_next = S.next(ui + 1, nxt);
        const char* nA = has_next ? PG8_UA(nxt) : cA; const char* nB = has_next ? PG8_UB(nxt) : cB;
        for (int t = 0; t < nt; t += 2) {
            const bool last = (t == nt - 2);
            const char* a1 = cA + (size_t)(t + 1) * kstep;
            const char* a2 = last ? nA : cA + (size_t)(t + 2) * kstep; const char* b2 = last ? nB : cB + (size_t)(t + 2) * kstep;
            const char* a3 = a2 + kstep; const char* b3 = b2 + kstep;
            PG8_LDB(B0, 0, 0); PG8_LDB(B1, 0, 1); PG8_SCHED; PG8_LDA(At, 0, 0); PG8_STAGE(PG8_SA(1, 1), a1 + hstepA, voffA);
            PG8_WAIT_V(8); PG8_WAIT_L(0); PG8_BAR; PG8_MMA(0, 0, At, B0); if (!DIAG) PG8_MMA(0, 1, At, B1); PG8_BAR; PG8_SCHED;
            PG8_LDA(At, 0, 1); PG8_STAGE(PG8_SB(0, 0), b2, voffB); PG8_STAGE(PG8_SB(0, 1), b2 + hstepB, voffB); PG8_STAGE(PG8_SA(0, 0), a2, voffA);
            PG8_WAIT_V(8); PG8_WAIT_L(0); PG8_BAR; if (!DIAG) PG8_MMA(1, 0, At, B0); PG8_MMA(1, 1, At, B1); PG8_BAR; PG8_SCHED;
            PG8_LDB(B0, 1, 0); PG8_LDB(B1, 1, 1); PG8_SCHED; PG8_LDA(At, 1, 0); PG8_STAGE(PG8_SA(0, 1), a2 + hstepA, voffA);
            PG8_WAIT_V(8); PG8_WAIT_L(0); PG8_BAR; PG8_MMA(0, 0, At, B0); if (!DIAG) PG8_MMA(0, 1, At, B1); PG8_BAR; PG8_SCHED;
            PG8_LDA(At, 1, 1); PG8_STAGE(PG8_SB(1, 0), b3, voffB); PG8_STAGE(PG8_SB(1, 1), b3 + hstepB, voffB); PG8_STAGE(PG8_SA(1, 0), a3, voffA);
            PG8_WAIT_V(8); PG8_WAIT_L(0); PG8_BAR; if (!DIAG) PG8_MMA(1, 0, At, B0); PG8_MMA(1, 1, At, B1); PG8_BAR; PG8_SCHED;
        }
        if (wr == 0) PG8_BAR;
        E(acc, cur, wr, wc, fr, fq);
        if (!has_next) break;
#pragma unroll
        for (int a = 0; a < 2; ++a)
#pragma unroll
            for (int b = 0; b < 2; ++b)
#pragma unroll
                for (int m = 0; m < 4; ++m)
#pragma unroll
                    for (int n = 0; n < 2; ++n) acc[a][b][m][n] = (f32x4){0.f, 0.f, 0.f, 0.f};
        cur = nxt; cA = nA; cB = nB; ++ui;
        if (wr == 1) PG8_BAR;
    }
    PG8_WAIT_V(0);
    PG8_BAR;
#undef PG8_SA
#undef PG8_SB
#undef PG8_STAGE
#undef PG8_LDA
#undef PG8_LDB
#undef PG8_MMA
#undef PG8_WAIT_V
#undef PG8_WAIT_L
#undef PG8_BAR
#undef PG8_SCHED
#undef PG8_UA
#undef PG8_UB
}

typedef const f32x4 (&AccRef)[2][2][4][2];

struct EpiStore {
    static constexpr bool PERM = true;
    bf16_t* O; int ldc; long zoff;
    __device__ __forceinline__ void operator()(AccRef acc, const Unit& u, int wr, int wc, int fr, int fq) const {
        bf16_t* base = O + (size_t)u.z * zoff + (size_t)(u.pm * BM + wr * 64 + fr) * ldc + u.pn * BM + wc * 32 + 8 * fq;
#pragma unroll
        for (int ai = 0; ai < 2; ++ai)
#pragma unroll
            for (int m = 0; m < 4; ++m) { bf16_t* rowp = base + (size_t)(ai * HALF + m * 16) * ldc;
#pragma unroll
                for (int bj = 0; bj < 2; ++bj) { const f32x4 v0 = acc[ai][bj][m][0], v1 = acc[ai][bj][m][1];
                    u32x4 w; w.x = cvt_pk_bf16(v0[0], v0[1]); w.y = cvt_pk_bf16(v0[2], v0[3]); w.z = cvt_pk_bf16(v1[0], v1[1]); w.w = cvt_pk_bf16(v1[2], v1[3]);
                    *(u32x4*)(rowp + bj * HALF) = w; } }
    }
};

struct EpiFT {
    static constexpr bool PERM = true;
    bf16_t* FT; bf16_t* FTc;
    __device__ __forceinline__ void operator()(AccRef acc, const Unit& u, int wr, int wc, int fr, int fq) const {
        const int tl = wc * 32 + 8 * fq;
        bf16_t* base; size_t rstride; int poff;
        if (u.pn < 128) { const int b = u.pn >> 4; const int n = ((u.pn & 15) << 8) + tl; base = FT + (size_t)b * 512 * 8192 + n; rstride = 8192; poff = 4096; }
        else { const int b = u.pn - 128; base = FTc + (size_t)b * 512 * 512 + tl; rstride = 512; poff = 256; }
#pragma unroll
        for (int ai = 0; ai < 2; ++ai)
#pragma unroll
            for (int m = 0; m < 4; ++m) { const int R = u.pm * BM + ai * HALF + wr * 64 + m * 16 + fr; const int part = R >> 9, c = R & 511;
                bf16_t* rowp = base + (size_t)c * rstride + part * poff;
#pragma unroll
                for (int bj = 0; bj < 2; ++bj) { const f32x4 v0 = acc[ai][bj][m][0], v1 = acc[ai][bj][m][1];
                    u32x4 w; w.x = cvt_pk_bf16(v0[0], v0[1]); w.y = cvt_pk_bf16(v0[2], v0[3]); w.z = cvt_pk_bf16(v1[0], v1[1]); w.w = cvt_pk_bf16(v1[2], v1[3]);
                    *(u32x4*)(rowp + bj * HALF) = w; } }
    }
};

struct EpiQKV {
    static constexpr bool PERM = true;
    bf16_t* Q; bf16_t* Kb; const float* rope;
    __device__ __forceinline__ void operator()(AccRef acc, const Unit& u, int wr, int wc, int fr, int fq) const {
        const bool isctx = u.pm >= (NLAT / BM);
#pragma unroll
        for (int ai = 0; ai < 2; ++ai) {
            f32x4 csa[4], csb[4];
#pragma unroll
            for (int m = 0; m < 4; ++m) { const int pos = (u.pm * BM + ai * HALF + wr * 64 + m * 16 + fr) & (SEQ - 1); const int pp = (wc & 1) ? (pos & 63) : (pos >> 6);
                csa[m] = (f32x4){1.f, 0.f, 1.f, 0.f}; csb[m] = csa[m];
                if (!isctx) { const f32x4* tp = (const f32x4*)(rope + (size_t)(pp * 16 + 4 * fq) * 2); csa[m] = tp[0]; csb[m] = tp[1]; } }
            asm volatile("" ::: "memory");
#pragma unroll
            for (int m = 0; m < 4; ++m) {
                const int R = u.pm * BM + ai * HALF + wr * 64 + m * 16 + fr;
                const int pos = R & (SEQ - 1);
                const f32x4 cs0 = csa[m], cs1 = csb[m];
#pragma unroll
                for (int bj = 0; bj < 2; ++bj) {
                    f32x4 v0 = acc[ai][bj][m][0], v1 = acc[ai][bj][m][1];
                    if (u.pn < 2 || bj == 0) {
                        f32x4 o0, o1;
                        o0[0] = v0[0] * cs0[0] - v0[1] * cs0[1]; o0[1] = v0[0] * cs0[1] + v0[1] * cs0[0];
                        o0[2] = v0[2] * cs0[2] - v0[3] * cs0[3]; o0[3] = v0[2] * cs0[3] + v0[3] * cs0[2];
                        o1[0] = v1[0] * cs1[0] - v1[1] * cs1[1]; o1[1] = v1[0] * cs1[1] + v1[1] * cs1[0];
                        o1[2] = v1[2] * cs1[2] - v1[3] * cs1[3]; o1[3] = v1[2] * cs1[3] + v1[3] * cs1[2];
                        if (u.pn < 2) { o0 = o0 * QSCALE; o1 = o1 * QSCALE; }
                        v0 = o0; v1 = o1;
                    }
                    u32x4 w; w.x = cvt_pk_bf16(v0[0], v0[1]); w.y = cvt_pk_bf16(v0[2], v0[3]); w.z = cvt_pk_bf16(v1[0], v1[1]); w.w = cvt_pk_bf16(v1[2], v1[3]);
                    if (u.pn < 2) *(u32x4*)(Q + (size_t)R * 512 + u.pn * BM + bj * HALF + wc * 32 + 8 * fq) = w;
                    else *(u32x4*)(Kb + (size_t)R * 256 + bj * HALF + wc * 32 + 8 * fq) = w;
                }
                asm volatile("" ::: "memory");
            }
        }
    }
};

struct EpiSwiGLU {
    static constexpr bool PERM = true;
    bf16_t* U;
    __device__ __forceinline__ void operator()(AccRef acc, const Unit& u, int wr, int wc, int fr, int fq) const {
        bf16_t* base = U + (size_t)(u.pm * BM + wr * 64 + fr) * FF + u.pn * HALF + wc * 32 + 8 * fq;
#pragma unroll
        for (int ai = 0; ai < 2; ++ai)
#pragma unroll
            for (int m = 0; m < 4; ++m) { bf16_t* rowp = base + (size_t)(ai * HALF + m * 16) * FF;
                f32x4 o0, o1; silu_mul8(acc[ai][0][m][0], acc[ai][1][m][0], acc[ai][0][m][1], acc[ai][1][m][1], o0, o1);
                u32x4 w; w.x = cvt_pk_bf16(o0[0], o0[1]); w.y = cvt_pk_bf16(o0[2], o0[3]); w.z = cvt_pk_bf16(o1[0], o1[1]); w.w = cvt_pk_bf16(o1[2], o1[3]);
                *(u32x4*)(rowp) = w; }
    }
};

template <class TB> struct EpiResH {
    static constexpr bool PERM = true;
    const TB* baseL; const TB* baseC; bf16_t* outL; bf16_t* outC; const float* gate;
    int zcol;
    static __device__ __forceinline__ void ld8(const float* p, f32x4& a, f32x4& b) { a = *(const f32x4*)p; b = *(const f32x4*)(p + 4); }
    static __device__ __forceinline__ void ld8(const bf16_t* p, f32x4& a, f32x4& b) { const u32x4 w = *(const u32x4*)p;
        a = (f32x4){__uint_as_float(w.x << 16), __uint_as_float(w.x & 0xffff0000u), __uint_as_float(w.y << 16), __uint_as_float(w.y & 0xffff0000u)};
        b = (f32x4){__uint_as_float(w.z << 16), __uint_as_float(w.z & 0xffff0000u), __uint_as_float(w.w << 16), __uint_as_float(w.w & 0xffff0000u)}; }
    __device__ __forceinline__ void operator()(AccRef acc, const Unit& u, int wr, int wc, int fr_, int fq_) const {
        int fr = fr_, fq = fq_; asm volatile("" : "+v"(fr), "+v"(fq));
        const int r0 = u.pm * BM; const TB* bs; bf16_t* os; int mb;
        if (r0 < NLAT) { bs = baseL + (size_t)r0 * D; os = outL + (size_t)r0 * D; mb = r0 >> 12; }
        else { bs = baseC + (size_t)(r0 - NLAT) * D; os = outC + (size_t)(r0 - NLAT) * D; mb = 8; }
        const int col0 = u.z * zcol + u.pn * BM + wc * 32 + 8 * fq;
        f32x4 gv[2][2];
#pragma unroll
        for (int bj = 0; bj < 2; ++bj)
#pragma unroll
            for (int n = 0; n < 2; ++n) gv[bj][n] = *(const f32x4*)(gate + (size_t)mb * MODW + col0 + bj * HALF + 4 * n);
#pragma unroll
        for (int ai = 0; ai < 2; ++ai) {
            f32x4 b4[4][2][2];
#pragma unroll
            for (int mm = 0; mm < 4; ++mm) { const unsigned off = (unsigned)((ai * HALF + wr * 64 + mm * 16 + fr) * D + col0);
#pragma unroll
                for (int bj = 0; bj < 2; ++bj) ld8(bs + off + bj * HALF, b4[mm][bj][0], b4[mm][bj][1]); }
            asm volatile("" ::: "memory");
#pragma unroll
            for (int mm = 0; mm < 4; ++mm) { const unsigned off = (unsigned)((ai * HALF + wr * 64 + mm * 16 + fr) * D + col0);
#pragma unroll
                for (int bj = 0; bj < 2; ++bj) { const f32x4 o0 = b4[mm][bj][0] + gv[bj][0] * acc[ai][bj][mm][0], o1 = b4[mm][bj][1] + gv[bj][1] * acc[ai][bj][mm][1];
                    u32x4 w; w.x = cvt_pk_bf16(o0[0], o0[1]); w.y = cvt_pk_bf16(o0[2], o0[3]); w.z = cvt_pk_bf16(o1[0], o1[1]); w.w = cvt_pk_bf16(o1[2], o1[3]);
                    *(u32x4*)(os + off + bj * HALF) = w; } }
            asm volatile("" ::: "memory"); }
    }
};
struct EpiDftSym {
    static constexpr bool PERM = true;
    bf16_t* MIXp; const float* a2048;
    __device__ __forceinline__ void operator()(AccRef acc, const Unit& u, int wr, int wc, int fr_, int fq_) const {
        int fr = fr_, fq = fq_; asm volatile("" : "+v"(fr), "+v"(fq));
        const int c0 = u.pn * HALF + wc * 32 + 8 * fq;
        const f32x4 t0 = *(const f32x4*)(a2048 + u.z * 512 + c0), t1 = *(const f32x4*)(a2048 + u.z * 512 + c0 + 4);
        const float sg2 = (fr & 1) ? -2.0f : 2.0f;
        bf16_t* base = MIXp + (size_t)u.z * SEQ * 1024 + c0;
#pragma unroll
        for (int m = 0; m < 4; ++m) { const int k = u.pm * HALF + wr * 64 + m * 16 + fr;
            const f32x4 u10 = acc[0][0][m][0], u11 = acc[0][0][m][1], u20 = acc[1][1][m][0], u21 = acc[1][1][m][1];
            const f32x4 y0 = u10 + u20, y1 = u11 + u21;
            u32x4 w; w.x = cvt_pk_bf16(y0[0], y0[1]); w.y = cvt_pk_bf16(y0[2], y0[3]); w.z = cvt_pk_bf16(y1[0], y1[1]); w.w = cvt_pk_bf16(y1[2], y1[3]);
            *(u32x4*)(base + (size_t)k * 1024) = w;
            if (k > 0) { const f32x4 z0 = u10 - u20 + t0 * sg2, z1 = u11 - u21 + t1 * sg2;
                u32x4 v; v.x = cvt_pk_bf16(z0[0], z0[1]); v.y = cvt_pk_bf16(z0[2], z0[3]); v.z = cvt_pk_bf16(z1[0], z1[1]); v.w = cvt_pk_bf16(z1[2], z1[3]);
                *(u32x4*)(base + (size_t)(SEQ - k) * 1024) = v; } }
    }
};
struct EpiPartial {
    static constexpr bool PERM = false;
    float* S; long zoff;
    __device__ __forceinline__ void operator()(AccRef acc, const Unit& u, int wr, int wc, int fr, int fq) const {
        float* os = S + (size_t)u.z * zoff + (size_t)(u.pm * BM) * D + u.pn * BM + wc * 32 + 4 * fq;
#pragma unroll
        for (int ai = 0; ai < 2; ++ai)
#pragma unroll
            for (int m = 0; m < 4; ++m) { const size_t off = (size_t)(ai * HALF + wr * 64 + m * 16 + fr) * D;
#pragma unroll
                for (int bj = 0; bj < 2; ++bj)
#pragma unroll
                    for (int n = 0; n < 2; ++n) *(f32x4*)(os + off + bj * HALF + n * 16) = acc[ai][bj][m][n]; }
    }
};
}

namespace att {
constexpr int KSTR = 144, VSTR = 264;
constexpr int KBUF = 128 * KSTR, VBUF = 64 * VSTR, BUF = KBUF + VBUF;
struct Args { const bf16_t* Q; const bf16_t* Kb; bf16_t* MIX; const float* sink; };
__device__ __forceinline__ int crow(int r, int hi) { return (r & 3) + 8 * (r >> 2) + 4 * hi; }

__device__ __forceinline__ void unit(LAS unsigned char* lds, const Args& A, int b, int blk, int kvh) {
    const int tid = opaque_tid(), lane = tid & 63, r32 = lane & 31, hi = lane >> 5, wid = __builtin_amdgcn_readfirstlane(tid >> 6);
    const bool cq = blk >= 32;
    const int hq = kvh * 4 + (wid >> 1);
    const int qloc = (wid & 1) * 64;
    const size_t qrow0 = cq ? (size_t)NLAT + b * CTX + (blk - 32) * 128 : (size_t)b * SEQ + blk * 128;
    bf16x8 qf[2][4];
#pragma unroll
    for (int qt = 0; qt < 2; ++qt)
#pragma unroll
        for (int ks = 0; ks < 4; ++ks) qf[qt][ks] = *(const bf16x8*)(A.Q + (qrow0 + qloc + qt * 32 + r32) * 512 + hq * 64 + ks * 16 + hi * 8);
    f32x16 o[2][2];
#pragma unroll
    for (int a = 0; a < 2; ++a)
#pragma unroll
        for (int c = 0; c < 2; ++c)
#pragma unroll
            for (int r = 0; r < 16; ++r) o[a][c][r] = 0.f;
    const float sk = A.sink[hq] * LOG2E;
    float mrow[2] = {sk, sk}, lrow[2] = {hi == 0 ? 1.f : 0.f, hi == 0 ? 1.f : 0.f};
    const int c_first = cq ? 3 : (blk == 0 ? 1 : 0);
    u32x4 kreg[2], vreg[2];
    auto next_chunk = [&](int c) { int n = c + 1; if (!cq && n == 2 && blk == 31) n = 3; return n; };
    auto gload = [&](int c) {
#pragma unroll
        for (int i = 0; i < 2; ++i) {
            const int p = tid + 512 * i;
            const int key = p >> 3, part = p & 7;
            size_t krow;
            if (c < 3) krow = (size_t)b * SEQ + blk * 128 + (c - 1) * 128 + key; else krow = (size_t)NLAT + b * CTX + (c - 3) * 128 + key;
            kreg[i] = *(const u32x4*)(A.Kb + krow * 256 + kvh * 64 + part * 8);
            vreg[i] = *(const u32x4*)(A.Kb + krow * 256 + 128 + kvh * 64 + part * 8);
        }
    };
    auto lstore = [&](int buf) {
        LAS unsigned char* kb = lds + buf * BUF; LAS unsigned char* vb = kb + KBUF;
#pragma unroll
        for (int i = 0; i < 2; ++i) {
            const int p = tid + 512 * i; const int key = p >> 3, part = p & 7;
            *(LAS u32x4*)(kb + key * KSTR + part * 16) = kreg[i];
            LAS unsigned short* vp = (LAS unsigned short*)(vb + (part * 8) * VSTR + key * 2);
            const unsigned x0 = vreg[i].x, x1 = vreg[i].y, x2 = vreg[i].z, x3 = vreg[i].w;
            vp[0 * (VSTR / 2)] = (unsigned short)(x0 & 0xffff); vp[1 * (VSTR / 2)] = (unsigned short)(x0 >> 16);
            vp[2 * (VSTR / 2)] = (unsigned short)(x1 & 0xffff); vp[3 * (VSTR / 2)] = (unsigned short)(x1 >> 16);
            vp[4 * (VSTR / 2)] = (unsigned short)(x2 & 0xffff); vp[5 * (VSTR / 2)] = (unsigned short)(x2 >> 16);
            vp[6 * (VSTR / 2)] = (unsigned short)(x3 & 0xffff); vp[7 * (VSTR / 2)] = (unsigned short)(x3 >> 16);
        }
    };
    gload(c_first); lstore(0); __syncthreads();
    int buf = 0;
    for (int c = c_first; c < 5;) {
        const int cn = next_chunk(c);
        if (cn < 5) gload(cn);
        LAS unsigned char* kb = lds + buf * BUF; LAS unsigned char* vb = kb + KBUF;
#pragma unroll 1
        for (int kt = 0; kt < 4; ++kt) {
            f32x16 s[2];
#pragma unroll
            for (int r = 0; r < 16; ++r) { s[0][r] = 0.f; s[1][r] = 0.f; }
#pragma unroll
            for (int ks = 0; ks < 4; ++ks) {
                const bf16x8 kf = *(const LAS bf16x8*)(kb + (kt * 32 + r32) * KSTR + (ks * 16 + hi * 8) * 2);
                s[0] = __builtin_amdgcn_mfma_f32_32x32x16_bf16(kf, qf[0][ks], s[0], 0, 0, 0);
                s[1] = __builtin_amdgcn_mfma_f32_32x32x16_bf16(kf, qf[1][ks], s[1], 0, 0, 0);
            }
            if (c == 0 || c == 2) {
#pragma unroll
                for (int qt = 0; qt < 2; ++qt) { const int q = qloc + qt * 32 + r32;
#pragma unroll
                    for (int r = 0; r < 16; ++r) { const int j = kt * 32 + crow(r, hi); const bool ok = (c == 0) ? (j >= q) : (j <= q); if (!ok) s[qt][r] = -INFINITY; } }
            }
            bf16x8 pb[2][2];
#pragma unroll
            for (int qt = 0; qt < 2; ++qt) {
                float mx = s[qt][0];
#pragma unroll
                for (int r = 1; r < 16; ++r) mx = fmaxf(mx, s[qt][r]);
                mx = fmaxf(mx, __shfl_xor(mx, 32));
                const float mnew = fmaxf(mrow[qt], mx);
                const float alpha = __builtin_amdgcn_exp2f(mrow[qt] - mnew);
                mrow[qt] = mnew;
                float ls = 0.f;
#pragma unroll
                for (int r = 0; r < 16; ++r) { const float pv = __builtin_amdgcn_exp2f(s[qt][r] - mnew); s[qt][r] = pv; ls += pv; }
                lrow[qt] = lrow[qt] * alpha + ls;
#pragma unroll
                for (int dt = 0; dt < 2; ++dt)
#pragma unroll
                    for (int r = 0; r < 16; ++r) o[dt][qt][r] *= alpha;
#pragma unroll
                for (int st = 0; st < 2; ++st) {
                    u32x4 w; w.x = cvt_pk_bf16(s[qt][8 * st + 0], s[qt][8 * st + 1]); w.y = cvt_pk_bf16(s[qt][8 * st + 2], s[qt][8 * st + 3]);
                    w.z = cvt_pk_bf16(s[qt][8 * st + 4], s[qt][8 * st + 5]); w.w = cvt_pk_bf16(s[qt][8 * st + 6], s[qt][8 * st + 7]);
                    pb[qt][st] = __builtin_bit_cast(bf16x8, w);
                }
            }
#pragma unroll
            for (int st = 0; st < 2; ++st)
#pragma unroll
                for (int dt = 0; dt < 2; ++dt) {
                    const LAS unsigned char* vp = vb + (dt * 32 + r32) * VSTR + (kt * 32 + st * 16 + hi * 4) * 2;
                    const u32x2 lo = *(const LAS u32x2*)vp, hh = *(const LAS u32x2*)(vp + 16);
                    const bf16x8 vf = __builtin_bit_cast(bf16x8, (u32x4){lo.x, lo.y, hh.x, hh.y});
                    o[dt][0] = __builtin_amdgcn_mfma_f32_32x32x16_bf16(vf, pb[0][st], o[dt][0], 0, 0, 0);
                    o[dt][1] = __builtin_amdgcn_mfma_f32_32x32x16_bf16(vf, pb[1][st], o[dt][1], 0, 0, 0);
                }
        }
        if (cn < 5) lstore(buf ^ 1);
        __syncthreads();
        buf ^= 1; c = cn;
    }
    {
        LAS unsigned char* stg = lds + wid * 9216;
#pragma unroll
        for (int qt = 0; qt < 2; ++qt) {
            const float lt = lrow[qt] + __shfl_xor(lrow[qt], 32);
            const float inv = 1.0f / lt;
            LAS unsigned char* srow = stg + (qt * 32 + r32) * 144 + 8 * hi;
#pragma unroll
            for (int dt = 0; dt < 2; ++dt)
#pragma unroll
                for (int g = 0; g < 4; ++g) {
                    u32x2 w; w.x = cvt_pk_bf16(o[dt][qt][4 * g] * inv, o[dt][qt][4 * g + 1] * inv); w.y = cvt_pk_bf16(o[dt][qt][4 * g + 2] * inv, o[dt][qt][4 * g + 3] * inv);
                    *(LAS u32x2*)(srow + dt * 64 + 16 * g) = w;
                }
        }
        asm volatile("s_waitcnt lgkmcnt(0)" ::: "memory");
        bf16_t* obase = A.MIX + (qrow0 + qloc) * 1024 + 512 + hq * 64;
#pragma unroll
        for (int i = 0; i < 8; ++i) { const int row = i * 8 + (lane >> 3), ch = lane & 7;
            const u32x4 v = *(const LAS u32x4*)(stg + row * 144 + ch * 16);
            *(u32x4*)(obase + (size_t)row * 1024 + ch * 8) = v; }
    }
    __syncthreads();
}
}


#define XB_TMO      128
#define XB_XCNT(j)  (256  + 64 * (j))
#define XB_XSUB(j)  (1280 + 64 * (j))
#define XB_XGEN(j)  (2304 + 64 * (j))
#define XB_TOP      3328
#define XB_TOPGEN   3392
#define XCD_BAR_WORDS 3456
#define XB_SPIN_CAP (1u << 18)
__device__ __forceinline__ unsigned xb_ld(unsigned* p)              { return __hip_atomic_load(p, __ATOMIC_RELAXED, __HIP_MEMORY_SCOPE_AGENT); }
__device__ __forceinline__ unsigned xb_add(unsigned* p, unsigned v) { return __hip_atomic_fetch_add(p, v, __ATOMIC_RELAXED, __HIP_MEMORY_SCOPE_AGENT); }
__device__ __forceinline__ unsigned xb_xcc_id() { return (unsigned)__builtin_amdgcn_s_getreg((3 << 11) | 20) & 0xFu; }
#define XB_SPIN(cond, bar) do { unsigned _sp = 0; while (cond) { __builtin_amdgcn_s_sleep(1); \
    if ((++_sp & 255u) == 0u) { if (xb_ld(&(bar)[XB_TMO])) break; if (_sp > XB_SPIN_CAP) { atomicAdd(&(bar)[XB_TMO], 1u); break; } } } } while (0)
struct XcdBarrier { unsigned* bar; unsigned x; volatile LAS unsigned* st; };
__device__ __forceinline__ XcdBarrier xcd_barrier_post(unsigned* bar, volatile LAS unsigned* st) {
    XcdBarrier b; b.bar = bar; b.x = xb_xcc_id(); b.st = st;
    if (threadIdx.x == 0) (void)xb_add(&bar[XB_XCNT(b.x)], 1u);
    return b;
}
__device__ __forceinline__ void xcd_barrier_complete(unsigned* bar, unsigned x, unsigned& nloc, unsigned& nx) {
    const unsigned G = gridDim.x * gridDim.y * gridDim.z;
    unsigned sum, cnt, mine, sp = 0u;
    for (;;) {
        sum = 0u; cnt = 0u; mine = 0u;
#pragma unroll
        for (unsigned j = 0; j < 16; ++j) { const unsigned c = xb_ld(&bar[XB_XCNT(j)]); sum += c; cnt += (c > 0u) ? 1u : 0u; mine = (j == x) ? c : mine; }
        if (sum == G) break;
        __builtin_amdgcn_s_sleep(1);
        if ((++sp & 255u) == 0u) { if (xb_ld(&bar[XB_TMO])) break; if (sp > XB_SPIN_CAP) { atomicAdd(&bar[XB_TMO], 1u); break; } }
    }
    nloc = mine > 0u ? mine : 1u; nx = cnt > 0u ? cnt : 1u;
}
__device__ __forceinline__ void xcd_barrier(const XcdBarrier& b) {
    asm volatile("s_waitcnt vmcnt(0)" ::: "memory");
    __syncthreads();
    if (threadIdx.x == 0) {
        unsigned* bar = b.bar;
        __builtin_amdgcn_s_waitcnt(0);
        unsigned nloc = b.st[0], nx = b.st[1];
        if (nloc == 0u) { xcd_barrier_complete(bar, b.x, nloc, nx); b.st[0] = nloc; b.st[1] = nx; }
        const unsigned old = xb_add(&bar[XB_XSUB(b.x)], 1u);
        const unsigned gen = old / nloc;
        if (old + 1u == (gen + 1u) * nloc) {
            __builtin_amdgcn_fence(__ATOMIC_RELEASE, "agent");
            asm volatile("s_waitcnt vmcnt(0)" ::: "memory");
            const unsigned og = xb_add(&bar[XB_TOP], 1u);
            const unsigned tg = og / nx;
            if (og + 1u == (tg + 1u) * nx) xb_add(&bar[XB_TOPGEN], 1u);
            else XB_SPIN(xb_ld(&bar[XB_TOPGEN]) == tg, bar);
            __builtin_amdgcn_fence(__ATOMIC_ACQUIRE, "agent");
            xb_add(&bar[XB_XGEN(b.x)], 1u);
            asm volatile("s_waitcnt vmcnt(0)" ::: "memory");
        } else {
            XB_SPIN(xb_ld(&bar[XB_XGEN(b.x)]) == gen, bar);
            __builtin_amdgcn_fence(__ATOMIC_ACQUIRE, "agent");
            asm volatile("s_waitcnt vmcnt(0)" ::: "memory");
        }
    }
    __syncthreads();
}

struct Params {
    const float *x, *c, *ctx, *c_ctx, *ada_w, *ada_b, *norm_mix_g, *norm_ffn_g, *mix_in_w, *mix_out_w, *attn_sink, *pool_w, *pool_scale, *ffn_w1, *ffn_w3, *ffn_w2, *final_g;
    float* out; unsigned char* ws;
};

__device__ __forceinline__ void tr_item(const float* W, int spitch, int ncols, bf16_t* WT, int dpitch, int mode, int roff, const float* nscale, LAS float* scr, int item, int lane) {
    const int nblk = ncols / 32, kb = item / nblk, nb = item % nblk, k0 = 64 * kb, n0 = 32 * nb;
    float tv[32];
#pragma unroll
    for (int i = 0; i < 32; ++i) tv[i] = W[(size_t)(k0 + 2 * i + (lane >> 5)) * spitch + n0 + (lane & 31)];
#pragma unroll
    for (int i = 0; i < 32; ++i) scr[(2 * i + (lane >> 5)) * 33 + (lane & 31)] = tv[i];
    asm volatile("s_waitcnt lgkmcnt(0)" ::: "memory");
    const int c = lane & 7;
#pragma unroll
    for (int j = 0; j < 4; ++j) { const int n = (lane >> 3) + 8 * j; const LAS float* s = scr + (8 * c) * 33 + n;
        const float sc = nscale ? nscale[n0 + n] : 1.0f;
        const int gn = n0 + n; const int drow = (mode == 0) ? (roff + gn) : ((gn >> 7) * 256 + (gn & 127) + roff);
        u32x4 o; o.x = cvt_pk_bf16(s[0 * 33] * sc, s[1 * 33] * sc); o.y = cvt_pk_bf16(s[2 * 33] * sc, s[3 * 33] * sc); o.z = cvt_pk_bf16(s[4 * 33] * sc, s[5 * 33] * sc); o.w = cvt_pk_bf16(s[6 * 33] * sc, s[7 * 33] * sc);
        *(u32x4*)(WT + (size_t)drow * dpitch + k0 + 8 * c) = o; }
    asm volatile("s_waitcnt lgkmcnt(0)" ::: "memory");
}

template <class TS>
__device__ __forceinline__ void norm_pass(const TS* srcL, const TS* srcC, const float* gvec, const float* modl, int shift_off, int scale_off, bf16_t* XN, int M, int gw, int NGW, const float* slab = nullptr, const float* sgate = nullptr) {
    const int lane = opaque_tid() & 63;
    for (int row0 = gw * 4; row0 < M; row0 += NGW * 4) {
        const TS* src; int mb;
        if (row0 < NLAT) { src = srcL + (size_t)row0 * D; mb = row0 >> 12; } else { src = srcC + (size_t)(row0 - NLAT) * D; mb = 8; }
        f32x4 v[4][4];
#pragma unroll
        for (int r = 0; r < 4; ++r)
#pragma unroll
            for (int j = 0; j < 4; ++j) v[r][j] = ld4(src + (size_t)r * D + lane * 4 + 256 * j);
        if (slab && row0 >= NLAT) {
#pragma unroll
            for (int r = 0; r < 4; ++r)
#pragma unroll
                for (int j = 0; j < 4; ++j) { const float* s0 = slab + (size_t)(row0 - NLAT + r) * D + lane * 4 + 256 * j;
                    v[r][j] = v[r][j] + *(const f32x4*)(sgate + lane * 4 + 256 * j) * (*(const f32x4*)s0 + *(const f32x4*)(s0 + (size_t)NCTX * D)); } }
        float rstd[4];
#pragma unroll
        for (int r = 0; r < 4; ++r) { float ss = 0.f;
#pragma unroll
            for (int j = 0; j < 4; ++j) ss += (v[r][j].x * v[r][j].x + v[r][j].y * v[r][j].y) + (v[r][j].z * v[r][j].z + v[r][j].w * v[r][j].w);
            rstd[r] = rsqrtf(wave_sum(ss) * (1.0f / D) + EPS); }
        const float* mrow = modl + (size_t)mb * MODW;
#pragma unroll
        for (int j = 0; j < 4; ++j) { const int c = lane * 4 + 256 * j;
            const f32x4 g4 = *(const f32x4*)(gvec + c), sc4 = *(const f32x4*)(mrow + scale_off + c), sh4 = *(const f32x4*)(mrow + shift_off + c);
            const f32x4 G4 = g4 * (sc4 + 1.0f);
#pragma unroll
            for (int r = 0; r < 4; ++r) { const f32x4 q = v[r][j] * rstd[r] * G4 + sh4;
                u32x2 w; w.x = cvt_pk_bf16(q.x, q.y); w.y = cvt_pk_bf16(q.z, q.w);
                ((u32x2*)(XN + (size_t)(row0 + r) * D) + lane)[64 * j] = w; } }
    }
}

template <int HALF>
__device__ __forceinline__ void pool_rows(const f32x2 (&v)[47], f32x2 G2, int t0, int N, bf16_t* po) {
    f32x2 S = (f32x2){0.f, 0.f};
#pragma unroll
    for (int i = 8 - HALF; i < 8 + HALF; ++i) S += v[i];
#pragma unroll
    for (int t = 0; t < 32; ++t) {
        const int tt = t0 + t;
        const int lo = (tt - HALF) > 0 ? (tt - HALF) : 0, hh = (tt + HALF) < N ? (tt + HALF) : N;
        const float icnt = 1.0f / (float)(hh - lo);
        const f32x2 r = G2 * (S * icnt - v[t + 8]);
        *(unsigned*)(po + (size_t)t * D) = cvt_pk_bf16(r.x, r.y);
        if (t < 31) S += v[t + 8 + HALF] - v[t + 8 - HALF];
    }
}
struct PoolItem { int t0, N, mb; const bf16_t* base; size_t orow0; };
__device__ __forceinline__ PoolItem pool_item(int item, const bf16_t* srcL, const bf16_t* srcC) {
    PoolItem q;
    if (item < 1024) { const int seq = item >> 7; q.t0 = (item & 127) * 32; q.N = SEQ; q.base = srcL + (size_t)seq * SEQ * D; q.mb = seq; q.orow0 = (size_t)seq * SEQ; }
    else { const int it = item - 1024; const int seq = it >> 3; q.t0 = (it & 7) * 32; q.N = CTX; q.base = srcC + (size_t)seq * CTX * D; q.mb = 8; q.orow0 = (size_t)NLAT + seq * CTX; }
    return q;
}
__device__ __forceinline__ void pool_load(f32x2 (&v)[47], const PoolItem& q, int c0) {
    const bf16_t* colp = q.base + c0;
#pragma unroll
    for (int i = 0; i < 47; ++i) { const int t = q.t0 - 8 + i; v[i] = (t >= 0 && t < q.N) ? ld2(colp + (size_t)t * D) : (f32x2){0.f, 0.f}; }
}
__device__ __forceinline__ void pool_pass(const bf16_t* srcL, const bf16_t* srcC, const float* gvec, const float* modl, int scale_off, bf16_t* PO, bool with_ctx, LAS float* lds_f, int G) {
    const int tid = opaque_tid(), lane = tid & 63, wave = tid >> 6;
    LAS float* part = lds_f;
    LAS float* srs = lds_f + 8 * 48;
    const int nitems = 1024 + (with_ctx ? 64 : 0);
    int q = 0; while ((q + 1) * G <= nitems) ++q;
    const int rem = nitems - q * G, bxi = (int)blockIdx.x;
    const int i0 = bxi * q + (bxi < rem ? bxi : rem), i1 = i0 + q + (bxi < rem ? 1 : 0);
    const int c0 = 2 * tid;
    const int grp = c0 >> 8;
    const f32x2 g2 = *(const f32x2*)(gvec + c0);
    if (i0 >= i1) return;
    f32x2 v[47], vn[47];
    PoolItem cur = pool_item(i0, srcL, srcC);
    pool_load(v, cur, c0);
    for (int item = i0; item < i1; ++item) {
        PoolItem nxt = cur;
        const bool has_next = item + 1 < i1;
        if (has_next) { nxt = pool_item(item + 1, srcL, srcC); pool_load(vn, nxt, c0); }
#pragma unroll
        for (int i = 0; i < 47; ++i) { const float s = wave_sum(v[i].x * v[i].x + v[i].y * v[i].y); if (lane == 0) part[wave * 48 + i] = s; }
        __syncthreads();
        if (tid < 47) { float s = 0.f;
#pragma unroll
            for (int w = 0; w < 8; ++w) s += part[w * 48 + tid];
            srs[tid] = rsqrtf(s * (1.0f / D) + EPS); }
        __syncthreads();
#pragma unroll
        for (int i = 0; i < 47; ++i) v[i] = v[i] * srs[i];
        const f32x2 sc2 = *(const f32x2*)(modl + (size_t)cur.mb * MODW + scale_off + c0);
        const f32x2 G2 = g2 * (sc2 + 1.0f);
        bf16_t* po = PO + (cur.orow0 + cur.t0) * D + c0;
        if (grp == 0) pool_rows<1>(v, G2, cur.t0, cur.N, po);
        else if (grp == 1) pool_rows<2>(v, G2, cur.t0, cur.N, po);
        else if (grp == 2) pool_rows<4>(v, G2, cur.t0, cur.N, po);
        else pool_rows<8>(v, G2, cur.t0, cur.N, po);
        __syncthreads();
        if (has_next) {
#pragma unroll
            for (int i = 0; i < 47; ++i) v[i] = vn[i];
            cur = nxt; }
    }
}

__device__ __forceinline__ float bf2f(unsigned short h) { return __uint_as_float((unsigned)h << 16); }
__device__ __forceinline__ void fold_pass(const bf16_t* FT, bf16_t* FTF, float* A2048, bf16_t* MIXp, int gw, int NGW) {
    const int lane = opaque_tid() & 63;
    for (int r = gw; r < 4096; r += NGW) {
        const bf16_t* a = FT + (size_t)r * 8192; bf16_t* o = FTF + (size_t)r * 4096;
        bf16x8 lo[2][4], mi[2][4]; unsigned short m0[2][4];
        const unsigned short a2048 = a[2048];
#pragma unroll
        for (int part = 0; part < 2; ++part)
#pragma unroll
            for (int j = 0; j < 4; ++j) { const bf16_t* s = a + part * 4096; const int n0 = 8 * (lane + 64 * j);
                lo[part][j] = *(const bf16x8*)(s + n0);
                mi[part][j] = *(const bf16x8*)(s + 4096 - n0 - 8);
                m0[part][j] = s[(n0 > 0) ? (4096 - n0) : 0]; }
        asm volatile("" ::: "memory");
        float alt = 0.f;
#pragma unroll
        for (int part = 0; part < 2; ++part) { const float sg = part ? -1.0f : 1.0f;
#pragma unroll
            for (int j = 0; j < 4; ++j) { const int n0 = 8 * (lane + 64 * j);
                float v[8];
                v[0] = bf2f((unsigned short)lo[part][j][0]) + sg * bf2f(m0[part][j]);
#pragma unroll
                for (int e = 1; e < 8; ++e) v[e] = bf2f((unsigned short)lo[part][j][e]) + sg * bf2f((unsigned short)mi[part][j][8 - e]);
                if (n0 == 0) v[0] = part ? bf2f(a2048) : bf2f((unsigned short)lo[part][j][0]);
                if (part == 0) alt += ((v[0] - v[1]) + (v[2] - v[3])) + ((v[4] - v[5]) + (v[6] - v[7]));
                u32x4 w; w.x = cvt_pk_bf16(v[0], v[1]); w.y = cvt_pk_bf16(v[2], v[3]); w.z = cvt_pk_bf16(v[4], v[5]); w.w = cvt_pk_bf16(v[6], v[7]);
                *(u32x4*)(o + part * 2048 + n0) = w; } }
        alt = wave_sum(alt);
        if (lane == 0) { const float a2 = bf2f(a2048) * (1.0f / 64.0f); A2048[r] = a2;
            MIXp[((size_t)(r >> 9) * SEQ + 2048) * 1024 + (r & 511)] = (bf16_t)(cvt_pk_bf16(alt * (1.0f / 64.0f) + a2, 0.f) & 0xffffu); }
    }
}

__device__ __forceinline__ void ffn_weights_convert(const Params& p, bf16_t* W13, bf16_t* W2, int l_lo, int l_hi, int widx, int nw, LAS float* scr) {
    const int lane = opaque_tid() & 63;
    constexpr int I_W = 16 * 88, I_2 = 44 * 32, I_L = 2 * I_W + I_2;
    const int n = (l_hi - l_lo) * I_L;
    for (int it = widx; it < n; it += nw) {
        const int l = l_lo + it / I_L; const int r = it % I_L;
        if (r < I_W) tr_item(p.ffn_w1 + (size_t)l * D * FF, FF, FF, W13 + (size_t)l * W13_L, D, 1, 0, nullptr, scr, r, lane);
        else if (r < 2 * I_W) tr_item(p.ffn_w3 + (size_t)l * D * FF, FF, FF, W13 + (size_t)l * W13_L, D, 1, 128, nullptr, scr, r - I_W, lane);
        else tr_item(p.ffn_w2 + (size_t)l * FF * D, D, D, W2 + (size_t)l * W2_L, FF, 0, 0, nullptr, scr, r - 2 * I_W, lane);
    }
}

__global__ void __launch_bounds__(512, 2) fwd_kernel(Params p) {
    extern __shared__ __attribute__((aligned(16))) unsigned char lds_raw[];
    LAS unsigned char* lds = (LAS unsigned char*)lds_raw;
    cg::grid_group grid = cg::this_grid();
    const int tid = threadIdx.x, lane = tid & 63, wave = __builtin_amdgcn_readfirstlane(tid >> 6);
    const int G = gridDim.x, bx = blockIdx.x;
    const int vcu = (G % 8 == 0) ? (bx % 8) * (G / 8) + bx / 8 : bx;
    const int gw = vcu * 8 + wave, NGW = G * 8;
    const int gtid = bx * 512 + tid, NT = G * 512;
    unsigned char* ws = p.ws;
    volatile LAS unsigned* bst = (volatile LAS unsigned*)(lds + 131072 + 1024);
    if (tid < 2) bst[tid] = 0u;
    __syncthreads();
    XcdBarrier xbar = xcd_barrier_post((unsigned*)(ws + WS_BAR), bst);
    float* MOD = (float*)(ws + WS_MOD); float* ROPE = (float*)(ws + WS_ROPE); bf16_t* DFT256 = (bf16_t*)(ws + WS_DFT256); bf16_t* HC = (bf16_t*)(ws + WS_HC); bf16_t* HB = (bf16_t*)(ws + WS_HB);
    bf16_t* DFT = (bf16_t*)(ws + WS_DFT); bf16_t* XN = (bf16_t*)(ws + WS_XN);
    bf16_t* W13 = (bf16_t*)(ws + WS_W13); bf16_t* W2 = (bf16_t*)(ws + WS_W2); bf16_t* WQKV = (bf16_t*)(ws + WS_WQKV); bf16_t* WF = (bf16_t*)(ws + WS_WF); bf16_t* WO = (bf16_t*)(ws + WS_WO); bf16_t* WP = (bf16_t*)(ws + WS_WP);
    bf16_t* U = (bf16_t*)(ws + WS_U); bf16_t* Qb = (bf16_t*)(ws + WS_Q); bf16_t* Kb = (bf16_t*)(ws + WS_K);
    float* A2048 = (float*)(ws + WS_DFT256 + 512 * 1024);
    bf16_t* FTF = (bf16_t*)(ws + WS_FTF); bf16_t* FT = (bf16_t*)(ws + WS_FT); bf16_t* FTc = (bf16_t*)(ws + WS_FTC); bf16_t* MIX = (bf16_t*)(ws + WS_MIX);

    {
        LAS float* sS = (LAS float*)lds;
        LAS float* sR = (LAS float*)(lds + 9 * 1024 * 4);
        for (int idx = tid; idx < 9 * 1024; idx += 512) { const int r = idx >> 10, k = idx & 1023; const float v = r < 8 ? p.c[r * 1024 + k] : p.c_ctx[k]; sS[idx] = v / (1.0f + __expf(-v)); }
        __syncthreads();
        for (int item = bx; item < 4 * 96; item += G) {
            const int layer = item / 96, j0 = (item % 96) * 64;
            const float* W = p.ada_w + (size_t)layer * D * MODW + j0 + lane;
            float a0 = 0.f, a1 = 0.f, a2 = 0.f, a3 = 0.f, a4 = 0.f, a5 = 0.f, a6 = 0.f, a7 = 0.f, a8 = 0.f;
#pragma unroll 1
            for (int kb = 0; kb < 128; kb += 32) {
                float wv[32];
#pragma unroll
                for (int e = 0; e < 32; ++e) wv[e] = W[(size_t)(wave * 128 + kb + e) * MODW];
#pragma unroll
                for (int e = 0; e < 32; ++e) { const int k = wave * 128 + kb + e;
                    a0 += sS[k] * wv[e]; a1 += sS[1024 + k] * wv[e]; a2 += sS[2048 + k] * wv[e]; a3 += sS[3072 + k] * wv[e]; a4 += sS[4096 + k] * wv[e];
                    a5 += sS[5120 + k] * wv[e]; a6 += sS[6144 + k] * wv[e]; a7 += sS[7168 + k] * wv[e]; a8 += sS[8192 + k] * wv[e]; } }
            LAS float* rr = sR + wave * 9 * 64 + lane;
            rr[0] = a0; rr[64] = a1; rr[128] = a2; rr[192] = a3; rr[256] = a4; rr[320] = a5; rr[384] = a6; rr[448] = a7; rr[512] = a8;
            __syncthreads();
            for (int o = tid; o < 576; o += 512) { const int r = o >> 6, l = o & 63; float s = 0.f;
#pragma unroll
                for (int w = 0; w < 8; ++w) s += sR[(w * 9 + r) * 64 + l];
                MOD[((size_t)layer * 9 + r) * MODW + j0 + l] = s + p.ada_b[(size_t)layer * MODW + j0 + l]; }
            __syncthreads();
        }
        {
            LAS float* wt = (LAS float*)lds;
            LAS float* tc = (LAS float*)(lds + 32 * 129 * 4);
            for (int item = bx; item < 256; item += G) {
                const int j = item >> 7, h = (item >> 5) & 3, k0 = (item & 31) * 32;
                __syncthreads();
                if (tid < 128) { const float t = (float)tid * (1.0f / 128.0f); tc[tid] = __builtin_amdgcn_cosf(t); tc[128 + tid] = __builtin_amdgcn_sinf(t); }
                for (int idx = tid; idx < 32 * 128; idx += 512) { const int kk = idx >> 7, i = idx & 127; wt[kk * 129 + i] = p.mix_in_w[((size_t)j * D + k0 + kk) * 1280 + h * 128 + i]; }
                __syncthreads();
                const int jj = tid & 127, kq = tid >> 7;
                float ac[8], as[8];
#pragma unroll
                for (int e = 0; e < 8; ++e) { ac[e] = 0.f; as[e] = 0.f; }
                for (int i = 0; i < 128; ++i) { const int ph = (i * jj) & 127; const float cv = tc[ph], sv = tc[128 + ph];
#pragma unroll
                    for (int e = 0; e < 8; ++e) { const float w = wt[(kq * 8 + e) * 129 + i]; ac[e] += w * cv; as[e] += w * sv; } }
                const float nrm = 0.08838834764831845f;
                u32x4 oc, os;
                oc.x = cvt_pk_bf16(ac[0] * nrm, ac[1] * nrm); oc.y = cvt_pk_bf16(ac[2] * nrm, ac[3] * nrm); oc.z = cvt_pk_bf16(ac[4] * nrm, ac[5] * nrm); oc.w = cvt_pk_bf16(ac[6] * nrm, ac[7] * nrm);
                os.x = cvt_pk_bf16(as[0] * nrm, as[1] * nrm); os.y = cvt_pk_bf16(as[2] * nrm, as[3] * nrm); os.z = cvt_pk_bf16(as[4] * nrm, as[5] * nrm); os.w = cvt_pk_bf16(as[6] * nrm, as[7] * nrm);
                bf16_t* dst = WF + (size_t)j * WF_L + (size_t)(h * 128 + jj) * D + k0 + kq * 8;
                *(u32x4*)dst = oc; *(u32x4*)(dst + (size_t)512 * D) = os;
            }
            __syncthreads();
        }
        {
            LAS float* scr = (LAS float*)(lds + wave * 8448);
            constexpr int I_QKV = 16 * 24, I_O = 16 * 32, I_E = I_QKV + I_O, I_P = 4 * 32;
            constexpr int NITEMS = 2 * I_E + 2 * I_P;
            ffn_weights_convert(p, W13, W2, 0, 1, gw, NGW, scr);
            for (int it = gw; it < NITEMS; it += NGW) {
                int r = it;
                if (r < 2 * I_E) { const int j = r / I_E; r -= j * I_E;
                    if (r < I_QKV) tr_item(p.mix_in_w + (size_t)j * D * 1280 + 512, 1280, 768, WQKV + (size_t)j * WQKV_L, D, 0, 0, nullptr, scr, r, lane);
                    else tr_item(p.mix_out_w + (size_t)j * D * D, D, D, WO + (size_t)j * WO_L, D, 0, 0, nullptr, scr, r - I_QKV, lane);
                    continue; }
                r -= 2 * I_E;
                { const int j = r / I_P; r -= j * I_P; const int gq = r / 32; r -= gq * 32;
                  tr_item(p.pool_w + ((size_t)j * 4 + gq) * 65536, 256, 256, WP + (size_t)j * WP_L + (size_t)gq * 65536, 256, 0, 0, p.pool_scale + (size_t)j * D + gq * 256, scr, r, lane); }
            }
        }
        for (int idx = gtid; idx < 2048 * 512; idx += NT) {
            const int k = idx >> 9, n0 = (idx & 511) * 8;
            float v[8];
#pragma unroll
            for (int e = 0; e < 8; ++e) { const int np = n0 + e; float r;
                if (np < 2048) r = __builtin_amdgcn_cosf((float)((k * np) & 4095) * (1.0f / 4096.0f));
                else if (np == 2048) r = (k & 1) ? -1.0f : 1.0f;
                else r = -__builtin_amdgcn_sinf((float)((k * (np - 2048)) & 4095) * (1.0f / 4096.0f));
                v[e] = r * (1.0f / 64.0f); }
            u32x4 o; o.x = cvt_pk_bf16(v[0], v[1]); o.y = cvt_pk_bf16(v[2], v[3]); o.z = cvt_pk_bf16(v[4], v[5]); o.w = cvt_pk_bf16(v[6], v[7]);
            *(u32x4*)(DFT + (size_t)k * 4096 + n0) = o;
        }
        for (int idx = gtid; idx < 256 * 64; idx += NT) {
            const int k = idx >> 6, n0 = (idx & 63) * 8; const bool sp = n0 >= 256; const int nn = n0 & 255;
            float v[8];
#pragma unroll
            for (int e = 0; e < 8; ++e) { const float t = (float)((k * (nn + e)) & 255) * (1.0f / 256.0f); v[e] = (sp ? -__builtin_amdgcn_sinf(t) : __builtin_amdgcn_cosf(t)) * (1.0f / 16.0f); }
            u32x4 o; o.x = cvt_pk_bf16(v[0], v[1]); o.y = cvt_pk_bf16(v[2], v[3]); o.z = cvt_pk_bf16(v[4], v[5]); o.w = cvt_pk_bf16(v[6], v[7]);
            *(u32x4*)(DFT256 + (size_t)k * 512 + n0) = o;
        }
        for (int idx = gtid; idx < 64 * 16; idx += NT) {
            const int pos = idx >> 4, f = idx & 15;
            const float inv = exp2f(-(float)f * (13.287712379549449f / 16.0f));
            const float turns = (float)pos * inv * 0.15915494309189535f;
            const float fr = turns - floorf(turns);
            ROPE[2 * idx] = __builtin_amdgcn_cosf(fr); ROPE[2 * idx + 1] = __builtin_amdgcn_sinf(fr);
        }
    }
    grid.sync();

    for (int layer = 0; layer < DEPTH; ++layer) {
        const float* modl = MOD + (size_t)layer * 9 * MODW;
        const int jj = layer >> 1;
        const bool upd_ctx = layer < 2;
        if ((layer & 1) == 0) {
            const int Mrows = MALL;
            if (layer == 0) norm_pass(p.x, p.ctx, p.norm_mix_g + (size_t)layer * D, modl, 0, D, XN, Mrows, gw, NGW);
            else norm_pass(HB, HC, p.norm_mix_g + (size_t)layer * D, modl, 0, D, XN, Mrows, gw, NGW, (const float*)(ws + WS_SLAB), MOD + ((size_t)1 * 9 + 8) * MODW + 5 * D);
            xcd_barrier(xbar);
            { pg8::Gemm g{XN, WQKV + (size_t)jj * WQKV_L, D, D, D, 0, 0}; pg8::Order S(Mrows / 256, 3, 1, G, vcu, 3);
              pg8::EpiQKV E{Qb, Kb, ROPE}; pg8::gemm_phase(lds, g, S, E); }
            { const int ntok = upd_ctx ? MALL : NLAT;
              pg8::Gemm g{WF + (size_t)jj * WF_L, XN, D, D, D, 0, 0}; pg8::Order S(4, ntok / 256, 1, G, G - 1 - vcu, 2);
              pg8::EpiFT E{FT, FTc}; pg8::gemm_phase(lds, g, S, E); }
            xcd_barrier(xbar);
            const bool ctx_dft_early = upd_ctx && G > 48;
            if (ctx_dft_early) {
                if (vcu >= 48) fold_pass(FT, FTF, A2048, MIX, (vcu - 48) * 8 + wave, (G - 48) * 8);
                else if (vcu >= 32) { pg8::Gemm g{DFT256, FTc, 512, 512, 512, 0, (long)512 * 512}; pg8::Order S(1, 2, 8, G, vcu - 32, 0);
                    pg8::EpiStore E{MIX + (size_t)NLAT * 1024, 1024, (long)CTX * 1024}; pg8::gemm_phase(lds, g, S, E); }
            } else fold_pass(FT, FTF, A2048, MIX, gw, NGW);
            { att::Args A{Qb, Kb, MIX, p.attn_sink + jj * 8};
              const int nun = 512 + (upd_ctx ? 32 : 0);
              for (int un = vcu; un < nun; un += G) {
                  int b, blk, kvh;
                  if (un < 512) { b = un >> 6; blk = (un >> 1) & 31; kvh = un & 1; } else { const int q = un - 512; b = q >> 2; blk = 32 + ((q >> 1) & 1); kvh = q & 1; }
                  att::unit(lds, A, b, blk, kvh);
              } }
            xcd_barrier(xbar);
            { pg8::Gemm g{DFT, FTF, 2048, 4096, 4096, 0, (long)512 * 4096, 4096, 4096, (long)128 * 4096 * 2, (long)128 * 4096 * 2};
              pg8::Order S(16, 4, 8, G, vcu, 3);
              pg8::EpiDftSym E{MIX, A2048}; pg8::gemm_phase<pg8::EpiDftSym, true>(lds, g, S, E); }
            if (upd_ctx && !(G > 48)) { pg8::Gemm g{DFT256, FTc, 512, 512, 512, 0, (long)512 * 512}; pg8::Order S(1, 2, 8, G, vcu, 0);
              pg8::EpiStore E{MIX + (size_t)NLAT * 1024, 1024, (long)CTX * 1024}; pg8::gemm_phase(lds, g, S, E); }
            xcd_barrier(xbar);
            { const int Mo = upd_ctx ? MALL : NLAT;
              pg8::Gemm g{MIX, WO + (size_t)jj * WO_L, D, D, D, 0, 0}; pg8::Order S(Mo / 256, 4, 1, G, vcu, 3);
              if (layer == 0) { pg8::EpiResH<float> E{p.x, p.ctx, HB, HC, modl + 2 * D, 0}; pg8::gemm_phase(lds, g, S, E); }
              else { pg8::EpiResH<bf16_t> E{HB, HC, HB, HC, modl + 2 * D, 0}; pg8::gemm_phase(lds, g, S, E); } }
            xcd_barrier(xbar);
        } else {
            pool_pass(HB, HC, p.norm_mix_g + (size_t)layer * D, modl, D, MIX, upd_ctx, (LAS float*)lds, G);
            xcd_barrier(xbar);
            { const int Mo = upd_ctx ? MALL : NLAT;
              pg8::Gemm g{MIX, WP + (size_t)jj * WP_L, 256, D, 256, 256, 65536}; pg8::Order S(Mo / 256, 1, 4, G, vcu, 3, 1);
              pg8::EpiResH<bf16_t> E{HB, HC, HB, HC, modl + 2 * D, 256}; pg8::gemm_phase(lds, g, S, E); }
            xcd_barrier(xbar);
        }
        const int Mf = upd_ctx ? MALL : NLAT;
        norm_pass(HB, HC, p.norm_ffn_g + (size_t)layer * D, modl, 3 * D, 4 * D, XN, Mf, gw, NGW);
        xcd_barrier(xbar);
        { pg8::Gemm g{XN, W13 + (size_t)layer * W13_L, D, D, D, 0, 0}; pg8::Order S(Mf / 256, 22, 1, G, vcu, 3);
          pg8::EpiSwiGLU E{U}; pg8::gemm_phase(lds, g, S, E); }
        xcd_barrier(xbar);
        { pg8::Gemm g{U, W2 + (size_t)layer * W2_L, FF, FF, FF, 0, 0}; pg8::Order S(NLAT / 256, 4, 1, G, vcu, 3);
          pg8::EpiResH<bf16_t> E{HB, HC, HB, HC, modl + 5 * D, 0}; pg8::gemm_phase(lds, g, S, E); }
        if (upd_ctx) {
            float* SL = (float*)(ws + WS_SLAB);
            { pg8::Gemm g{U + (size_t)NLAT * FF, W2 + (size_t)layer * W2_L, FF / 2, FF, FF, FF / 2, FF / 2}; pg8::Order S(NCTX / 256, 4, 2, G, vcu, 3);
              pg8::EpiPartial E{SL, (long)NCTX * D}; pg8::gemm_phase(lds, g, S, E); }
            { const int cb = (G > 64) ? 64 : 0;
              if (vcu >= cb) ffn_weights_convert(p, W13, W2, layer == 0 ? 1 : 2, layer == 0 ? 2 : 4, (vcu - cb) * 8 + wave, (G - cb) * 8, (LAS float*)(lds + wave * 8448)); }
            if (layer == 0) {
            xcd_barrier(xbar);
            { const int lane_c = opaque_tid() & 63; const float* g2 = modl + (size_t)8 * MODW + 5 * D;
              for (int row = gw; row < NCTX; row += NGW) {
                  bf16_t* hr = HC + (size_t)row * D + lane_c * 4; const f32x4* s0 = (const f32x4*)(SL + (size_t)row * D) + lane_c; const f32x4* s1 = s0 + (size_t)NCTX * D / 4;
                  f32x4 hv[4], sa[4], sb[4];
#pragma unroll
                  for (int j = 0; j < 4; ++j) { hv[j] = ld4(hr + 256 * j); sa[j] = s0[64 * j]; sb[j] = s1[64 * j]; }
                  asm volatile("" ::: "memory");
#pragma unroll
                  for (int j = 0; j < 4; ++j) { const f32x4 o = hv[j] + *(const f32x4*)(g2 + lane_c * 4 + 256 * j) * (sa[j] + sb[j]);
                      u32x2 w; w.x = cvt_pk_bf16(o.x, o.y); w.y = cvt_pk_bf16(o.z, o.w); *(u32x2*)(hr + 256 * j) = w; } } }
            }
        }
        xcd_barrier(xbar);
    }
    { const int lane_f = opaque_tid() & 63;
      f32x4 g4[4];
#pragma unroll
      for (int j = 0; j < 4; ++j) g4[j] = *(const f32x4*)(p.final_g + lane_f * 4 + 256 * j);
      for (int row0 = gw * 4; row0 < NLAT; row0 += NGW * 4) {
        f32x4* xr = (f32x4*)(p.out + (size_t)row0 * D) + lane_f;
        f32x4 v[4][4];
#pragma unroll
        for (int r = 0; r < 4; ++r)
#pragma unroll
            for (int j = 0; j < 4; ++j) v[r][j] = ld4(HB + (size_t)(row0 + r) * D + lane_f * 4 + 256 * j);
#pragma unroll
        for (int r = 0; r < 4; ++r) { float ss = 0.f;
#pragma unroll
            for (int j = 0; j < 4; ++j) ss += (v[r][j].x * v[r][j].x + v[r][j].y * v[r][j].y) + (v[r][j].z * v[r][j].z + v[r][j].w * v[r][j].w);
            const float rstd = rsqrtf(wave_sum(ss) * (1.0f / D) + EPS);
#pragma unroll
            for (int j = 0; j < 4; ++j) xr[r * (D / 4) + 64 * j] = v[r][j] * rstd * g4[j]; }
      } }
}

extern "C" void kernel_launch(void* const* d_in, const int* in_sizes, int n_in, void* d_out, int out_size, void* d_ws, size_t ws_size, hipStream_t stream) {
    static int grid_blocks = 0;
    if (grid_blocks == 0) {
        if (n_in != 17 || ws_size < WS_END) { fprintf(stderr, "kernel_launch: unexpected inputs (n_in %d, ws %zu)\n", n_in, ws_size); grid_blocks = -1; return; }
        int dev = 0, cus = 0, per_cu = 0;
        hipGetDevice(&dev);
        hipDeviceGetAttribute(&cus, hipDeviceAttributeMultiprocessorCount, dev);
        hipFuncSetAttribute((const void*)fwd_kernel, hipFuncAttributeMaxDynamicSharedMemorySize, LDS_BYTES);
        hipOccupancyMaxActiveBlocksPerMultiprocessor(&per_cu, (const void*)fwd_kernel, 512, LDS_BYTES);
        if (per_cu < 1) { fprintf(stderr, "kernel_launch: occupancy query gave %d\n", per_cu); per_cu = 1; }
        (void)hipGetLastError();
        grid_blocks = cus;
    }
    if (grid_blocks < 0) return;
    (void)hipMemsetAsync((unsigned char*)d_ws + WS_BAR, 0, BAR_BYTES, stream);
    Params p{};
    const float** pf = (const float**)&p;
    for (int i = 0; i < 17; ++i) pf[i] = (const float*)d_in[i];
    p.out = (float*)d_out; p.ws = (unsigned char*)d_ws;
    void* args[] = {&p};
    hipError_t e = hipLaunchCooperativeKernel((const void*)fwd_kernel, dim3(grid_blocks), dim3(512), args, LDS_BYTES, stream);
    if (e != hipSuccess) fprintf(stderr, "cooperative launch failed: %s (grid %d)\n", hipGetErrorString(e), grid_blocks);
}
```
